# Optimizing an MI355X kernel written in HIP

```python
import math
import jax
import jax.numpy as jnp
from jax import lax
import numpy as np

D_MODEL = 2048
BATCH = 4
SEQ = 2048
DEPTH = 4

N_MIXERS = 2
N_ATT_LAYERS = (DEPTH + 1) // 2
N_REC_LAYERS = DEPTH // 2
NORM_EPS = 1e-6
MASK_VALUE = -1e30
LB_FLOOR = 1e-30

DILATED_GROUPS = ((128, 1), (512, 4), (2048, 16))
N_GROUPS = len(DILATED_GROUPS)
ATT_HEAD_DIM = 128
ATT_HEADS_PER_GROUP = D_MODEL // 256
ATT_BLOCK = 128
ROPE_THETA = 500000.0
ROPE_DIM = ATT_HEAD_DIM // 4
ATT_IN_WIDTH = N_GROUPS * 3 * ATT_HEADS_PER_GROUP * ATT_HEAD_DIM
ATT_OUT_WIDTH = ATT_HEADS_PER_GROUP * ATT_HEAD_DIM

HGRN_EXPAND = 128
HGRN_HEADS = D_MODEL // HGRN_EXPAND
HGRN_DK = HGRN_EXPAND
HGRN_DV = D_MODEL // HGRN_HEADS
HGRN_CHUNK = 16
HGRN_IN_WIDTH = 4 * D_MODEL

D_FF = 4 * D_MODEL

kernel_name = "hybrid_dilated_attn_hgrn2_trunk"


def rms_norm(x, g):
    xf = x.astype(jnp.float32)
    xf = xf * lax.rsqrt(jnp.mean(xf * xf, axis=-1, keepdims=True) + NORM_EPS)
    return xf.astype(x.dtype) * g


def partial_rope(x, positions):
    half = ROPE_DIM // 2
    inv_freq = ROPE_THETA ** (-jnp.arange(half, dtype=jnp.float32) / half)
    ang = positions.astype(jnp.float32)[..., None] * inv_freq
    cos = jnp.cos(ang)[:, :, None, :]
    sin = jnp.sin(ang)[:, :, None, :]
    xr = x[..., :ROPE_DIM].astype(jnp.float32)
    x1, x2 = xr[..., :half], xr[..., half:]
    rot = jnp.concatenate([x1 * cos - x2 * sin, x2 * cos + x1 * sin], axis=-1).astype(x.dtype)
    return jnp.concatenate([rot, x[..., ROPE_DIM:]], axis=-1)


def strided_window_attention(q, k, v, dilation, steps):
    B, S, H, dh = q.shape
    L = S // dilation
    N = B * dilation
    nb = -(-L // ATT_BLOCK)
    pad = nb * ATT_BLOCK - L

    def to_blocks(t):
        t = t.reshape(B, L, dilation, H, dh).transpose(0, 2, 1, 3, 4).reshape(N, L, H, dh)
        t = jnp.pad(t, ((0, 0), (0, pad), (0, 0), (0, 0)))
        return t.reshape(N, nb, ATT_BLOCK, H, dh)

    def with_prev(t):
        prev = jnp.concatenate([jnp.zeros_like(t[:, :1]), t[:, :-1]], axis=1)
        return jnp.concatenate([prev, t], axis=2)

    qb = to_blocks(q)
    kk = with_prev(to_blocks(k))
    vv = with_prev(to_blocks(v))

    scores = jnp.einsum('nbqhd,nbkhd->nbhqk', qb, kk).astype(jnp.float32) * (dh ** -0.5)
    blk = jnp.arange(nb)[:, None, None]
    qi = jnp.arange(ATT_BLOCK)[None, :, None] + ATT_BLOCK
    kj = jnp.arange(2 * ATT_BLOCK)[None, None, :]
    dist = qi - kj
    mask = (dist >= 0) & (dist <= steps) & ((blk > 0) | (kj >= ATT_BLOCK))
    scores = jnp.where(mask[None, :, None], scores, MASK_VALUE)
    m = jnp.max(scores, axis=-1, keepdims=True)
    p = jnp.exp(scores - m)
    l = jnp.sum(p, axis=-1, keepdims=True)
    out = jnp.einsum('nbhqk,nbkhd->nbqhd', (p / l).astype(v.dtype), vv)
    lse = (m + jnp.log(l))[..., 0]

    out = out.reshape(N, nb * ATT_BLOCK, H, dh)[:, :L]
    out = out.reshape(B, dilation, L, H, dh).transpose(0, 2, 1, 3, 4).reshape(B, S, H, dh)
    lse = lse.transpose(0, 1, 3, 2).reshape(N, nb * ATT_BLOCK, H)[:, :L]
    lse = lse.reshape(B, dilation, L, H).transpose(0, 2, 1, 3).reshape(B, S, H)
    return out, lse


def dilated_attention_mixer(u, positions, w_in, w_out):
    B, S, _ = u.shape
    proj = (u @ w_in).reshape(B, S, N_GROUPS, 3, ATT_HEADS_PER_GROUP, ATT_HEAD_DIM)
    outs, lses = [], []
    for g, (window, dilation) in enumerate(DILATED_GROUPS):
        q = partial_rope(proj[:, :, g, 0], positions)
        k = partial_rope(proj[:, :, g, 1], positions)
        v = proj[:, :, g, 2]
        o, lse = strided_window_attention(q, k, v, dilation, window // dilation)
        outs.append(o)
        lses.append(lse)
    w = jax.nn.softmax(jnp.stack(lses, axis=0), axis=0)
    o = jnp.sum(w[..., None] * jnp.stack(outs, axis=0).astype(jnp.float32), axis=0)
    return o.astype(u.dtype).reshape(B, S, ATT_OUT_WIDTH) @ w_out


def hgrn2_mixer(u, lower_bound, out_norm_g, w_in, w_out):
    B, S, _ = u.shape
    H, C = HGRN_HEADS, HGRN_CHUNK
    nC = S // C
    proj = (u @ w_in).reshape(B, S, 4, H, HGRN_DK)
    q, f_pre, i_val, gate = proj[:, :, 0], proj[:, :, 1], proj[:, :, 2], proj[:, :, 3]
    lb = lower_bound.astype(jnp.float32).reshape(H, HGRN_DK)
    log_f = jnp.logaddexp(jnp.log(jnp.maximum(lb, LB_FLOOR)),
                          jnp.log1p(-lb) + jax.nn.log_sigmoid(f_pre.astype(jnp.float32)))
    k = -jnp.expm1(log_f)

    def chunks(t):
        return t.astype(jnp.float32).reshape(B, nC, C, H, t.shape[-1]).transpose(1, 0, 3, 2, 4)

    causal = jnp.tril(jnp.ones((C, C), dtype=bool))[None, None, :, :, None]

    def step(state, inp):
        q_c, k_c, v_c, g_c = inp
        b = jnp.cumsum(g_c, axis=2)
        inter = jnp.einsum('bhtk,bhkv->bhtv', q_c * jnp.exp(b), state)
        diff = b[:, :, :, None, :] - b[:, :, None, :, :]
        decay = jnp.exp(jnp.where(causal, diff, MASK_VALUE))
        a = jnp.einsum('bhtk,bhsk,bhtsk->bhts', q_c, k_c, decay)
        intra = jnp.einsum('bhts,bhsv->bhtv', a, v_c)
        b_last = b[:, :, -1:, :]
        new_state = jnp.exp(b_last[:, :, 0, :])[..., None] * state + jnp.einsum(
            'bhsk,bhsv->bhkv', k_c * jnp.exp(b_last - b), v_c)
        return new_state, inter + intra

    state0 = jnp.zeros((B, H, HGRN_DK, HGRN_DV), jnp.float32)
    _, o = lax.scan(step, state0, (chunks(q), chunks(k), chunks(i_val), chunks(log_f)))
    o = o.transpose(1, 0, 3, 2, 4).reshape(B, S, H, HGRN_DV)
    o = rms_norm(o, out_norm_g) * jax.nn.silu(gate.astype(jnp.float32))
    return o.reshape(B, S, H * HGRN_DV).astype(u.dtype) @ w_out


def squared_relu_mlp(u, w1, w2):
    return jnp.square(jax.nn.relu(u @ w1)) @ w2


def setup_inputs(seed: int = 0) -> dict:
    key = jax.random.key(seed)
    ks = jax.random.split(key, 12)
    f32 = jnp.float32
    x = jax.random.normal(ks[0], (BATCH, SEQ, D_MODEL), f32)
    offsets = jax.random.randint(ks[1], (BATCH, 1), 0, 4096, dtype=jnp.int32)
    positions = offsets + jnp.arange(SEQ, dtype=jnp.int32)[None, :]
    norm_gains = 1.0 + 0.02 * jax.random.normal(ks[2], (DEPTH, 4, D_MODEL), f32)
    w_att_in = jax.random.normal(ks[3], (N_ATT_LAYERS, D_MODEL, ATT_IN_WIDTH), f32) * D_MODEL ** -0.5
    w_att_out = jax.random.normal(ks[4], (N_ATT_LAYERS, ATT_OUT_WIDTH, D_MODEL), f32) * ATT_OUT_WIDTH ** -0.5
    w_rec_in = jax.random.normal(ks[5], (N_REC_LAYERS, D_MODEL, HGRN_IN_WIDTH), f32) * D_MODEL ** -0.5
    rec_lower_bounds = 0.5 * jax.random.normal(ks[6], (N_REC_LAYERS, HGRN_HEADS * HGRN_DK), f32)
    rec_out_norm = 1.0 + 0.02 * jax.random.normal(ks[7], (N_REC_LAYERS, HGRN_DV), f32)
    w_rec_out = jax.random.normal(ks[8], (N_REC_LAYERS, HGRN_HEADS * HGRN_DV, D_MODEL), f32) * D_MODEL ** -0.5
    w_ff1 = jax.random.normal(ks[9], (DEPTH, D_MODEL, D_FF), f32) * D_MODEL ** -0.5
    w_ff2 = jax.random.normal(ks[10], (DEPTH, D_FF, D_MODEL), f32) * D_FF ** -0.5
    return {"x": x, "positions": positions, "norm_gains": norm_gains,
            "w_att_in": w_att_in, "w_att_out": w_att_out,
            "w_rec_in": w_rec_in, "rec_lower_bounds": rec_lower_bounds,
            "rec_out_norm": rec_out_norm, "w_rec_out": w_rec_out,
            "w_ff1": w_ff1, "w_ff2": w_ff2}


def reference(x, positions, norm_gains, w_att_in, w_att_out, w_rec_in, rec_lower_bounds,
              rec_out_norm, w_rec_out, w_ff1, w_ff2):
    lb = jax.nn.softmax(rec_lower_bounds.astype(jnp.float32), axis=0)
    lb = jnp.cumsum(lb, axis=0) - lb[0:1]
    h = x
    for layer in range(DEPTH):
        g = norm_gains[layer]
        u = rms_norm(h, g[0])
        j = layer // N_MIXERS
        if layer % N_MIXERS == 0:
            y = dilated_attention_mixer(u, positions, w_att_in[j], w_att_out[j])
        else:
            y = hgrn2_mixer(u, lb[j], rec_out_norm[j], w_rec_in[j], w_rec_out[j])
        h = h + rms_norm(y, g[1])
        u = rms_norm(h, g[2])
        h = h + rms_norm(squared_relu_mlp(u, w_ff1[layer], w_ff2[layer]), g[3])
    return h
```

```cpp
#include <hip/hip_runtime.h>
#include <cstdio>
#include <cstdint>

constexpr int BATCH = 4, SEQ = 2048, D = 2048, DEPTH = 4;
constexpr int M = BATCH * SEQ;
constexpr int ATT_IN = 9216, ATT_OUT = 1024, REC_IN = 8192, DFF = 8192;
constexpr int HD = 128;
constexpr float NORM_EPS = 1e-6f;
constexpr float QSCALE = 0.08838834764831845f * 1.4426950408889634f;

namespace pg8 {
#define PG8_LAS __attribute__((address_space(3)))
typedef unsigned short bf16_t;
typedef short bf16x8 __attribute__((ext_vector_type(8)));
typedef float f32x4 __attribute__((ext_vector_type(4)));
typedef unsigned u32x4 __attribute__((ext_vector_type(4)));
constexpr int BM = 256, BK = 64, HALF = 128, HTB = HALF * BK * 2  , STAGE_BYTES = 8 * HTB, NXCD = 8, WGM = 8;

__host__ __device__ __forceinline__ int lds_byte(int r, int c) { const int st = (r >> 4) * 2 + (c >> 5), rr = r & 15, cc = c & 31, ob = rr * 64 + cc * 2; return st * 1024 + (ob ^ (((ob >> 9) & 1) << 5)); }
__host__ __device__ __forceinline__ void stage_rc(int b, int& R, int& C) { const int st = b / 1024, sb = b % 1024, swz = sb ^ (((sb >> 9) & 1) << 5); R = (st >> 1) * 16 + swz / 64; C = (st & 1) * 32 + (swz % 64) / 2; }
__host__ __device__ __forceinline__ int perm32(int rho) { const int n = rho >> 4, i = rho & 15; return 8 * (i >> 2) + 4 * n + (i & 3); }

struct Unit { int pm, pn; };
struct Gemm { const bf16_t* A; const bf16_t* Bt; int M, N, K; };

struct StaticOrder {
    int nM, nN, nwg, G, c;
    __host__ __device__ void init(int M, int N, int G_, int c_) { nM = M / BM; nN = N / BM; nwg = nM * nN; G = G_; c = c_; }
    __host__ __device__ bool next(int i, Unit& u) const {
        const long L = (long)i * G + c; if (L >= nwg) return false;
        int wgid = (int)L; { const int q = nwg / NXCD, r = nwg % NXCD, xcd = wgid % NXCD, off = wgid / NXCD; wgid = (xcd < r ? xcd * (q + 1) : r * (q + 1) + (xcd - r) * q) + off; }
        const int nig = WGM * nN, gid = wgid / nig, fm = gid * WGM, gsz = (nM - fm) < WGM ? (nM - fm) : WGM;
        u.pm = fm + ((wgid % nig) % gsz); u.pn = (wgid % nig) / gsz; return true;
    }
    __device__ __forceinline__ void a_ready(const Unit&) const {}
    __device__ __forceinline__ void done(const Unit&) const {}
};

__device__ __forceinline__ unsigned cvt_pk_bf16(float lo, float hi) { unsigned r; asm volatile("v_cvt_pk_bf16_f32 %0, %1, %2" : "=v"(r) : "v"(lo), "v"(hi)); return r; }

struct EpiF32 {
    static constexpr bool PERM = false, AFTER_DRAIN = false;
    float* C; int ldc;
    __device__ __forceinline__ void operator()(const f32x4 (&acc)[2][2][4][2], const Unit& u, int wr, int wc, int fr, int fq) const {
        const int row0 = u.pm * BM + wr * 64 + fr, col0 = u.pn * BM + wc * 32 + 4 * fq;
#pragma unroll
        for (int ai = 0; ai < 2; ++ai)
#pragma unroll
            for (int m = 0; m < 4; ++m) { float* rowp = C + (size_t)(row0 + ai * HALF + m * 16) * ldc + col0;
#pragma unroll
                for (int bj = 0; bj < 2; ++bj)
#pragma unroll
                    for (int n = 0; n < 2; ++n) *(f32x4*)(rowp + bj * HALF + n * 16) = acc[ai][bj][m][n]; }
    }
};
template <int ACT  > struct EpiBf16 {
    static constexpr bool PERM = true, AFTER_DRAIN = false;
    bf16_t* O; int ldc;
    __device__ __forceinline__ void operator()(const f32x4 (&acc)[2][2][4][2], const Unit& u, int wr, int wc, int fr, int fq) const {
        const int row0 = u.pm * BM + wr * 64 + fr, col0 = u.pn * BM + wc * 32 + 8 * fq;
#pragma unroll
        for (int ai = 0; ai < 2; ++ai)
#pragma unroll
            for (int m = 0; m < 4; ++m) { bf16_t* rowp = O + (size_t)(row0 + ai * HALF + m * 16) * ldc + col0;
#pragma unroll
                for (int bj = 0; bj < 2; ++bj) { f32x4 v0 = acc[ai][bj][m][0], v1 = acc[ai][bj][m][1];
                    if (ACT == 1) {
#pragma unroll
                        for (int j = 0; j < 4; ++j) { const float a = fmaxf(v0[j], 0.f), b = fmaxf(v1[j], 0.f); v0[j] = a * a; v1[j] = b * b; } }
                    u32x4 w; w.x = cvt_pk_bf16(v0[0], v0[1]); w.y = cvt_pk_bf16(v0[2], v0[3]); w.z = cvt_pk_bf16(v1[0], v1[1]); w.w = cvt_pk_bf16(v1[2], v1[3]);
                    *(u32x4*)(rowp + bj * HALF) = w; } }
    }
};
struct EpiQKV {
    static constexpr bool PERM = true, AFTER_DRAIN = false;
    bf16_t* O; int ldc; const float* cs; const float* sn; float qscale;
    __device__ __forceinline__ void operator()(const f32x4 (&acc)[2][2][4][2], const Unit& u, int wr, int wc, int fr, int fq) const {
        const int row0 = u.pm * BM + wr * 64 + fr, col0 = u.pn * BM + wc * 32 + 8 * fq;
        const int t = (u.pn % 12) >> 2;
        const bool rope = (t < 2) && (wc == 0);
        const float sc = (t == 0) ? qscale : 1.0f;
        const bool upper = fq >= 2;
#pragma unroll
        for (int ai = 0; ai < 2; ++ai)
#pragma unroll
            for (int m = 0; m < 4; ++m) { const int row = row0 + ai * HALF + m * 16; bf16_t* rowp = O + (size_t)row * ldc + col0;
                f32x4 c0 = {1.f, 1.f, 1.f, 1.f}, c1 = c0, s0 = {0.f, 0.f, 0.f, 0.f}, s1 = s0;
                if (rope) { const float* cp = cs + (size_t)row * 16 + 8 * (fq & 1); const float* sp = sn + (size_t)row * 16 + 8 * (fq & 1);
                    c0 = *(const f32x4*)cp; c1 = *(const f32x4*)(cp + 4); s0 = *(const f32x4*)sp; s1 = *(const f32x4*)(sp + 4); }
#pragma unroll
                for (int bj = 0; bj < 2; ++bj) { f32x4 v0 = acc[ai][bj][m][0], v1 = acc[ai][bj][m][1];
                    if (rope) {
#pragma unroll
                        for (int j = 0; j < 4; ++j) {
                            const float p0 = __shfl_xor(v0[j], 32), p1 = __shfl_xor(v1[j], 32);
                            v0[j] = upper ? (v0[j] * c0[j] + p0 * s0[j]) : (v0[j] * c0[j] - p0 * s0[j]);
                            v1[j] = upper ? (v1[j] * c1[j] + p1 * s1[j]) : (v1[j] * c1[j] - p1 * s1[j]); } }
                    v0 = v0 * sc; v1 = v1 * sc;
                    u32x4 w; w.x = cvt_pk_bf16(v0[0], v0[1]); w.y = cvt_pk_bf16(v0[2], v0[3]); w.z = cvt_pk_bf16(v1[0], v1[1]); w.w = cvt_pk_bf16(v1[2], v1[3]);
                    *(u32x4*)(rowp + bj * HALF) = w; } }
    }
};

template <class Epi, class Sched, bool ALIGN_EPI = false, bool SP2 = false>
__device__ __forceinline__ void gemm_phase(PG8_LAS unsigned char* lds, const Gemm g, const Sched& S, const Epi& E) {
    int tid_ = threadIdx.x; asm volatile("" : "+v"(tid_));
    const int tid = tid_, wid = __builtin_amdgcn_readfirstlane(tid >> 6), lane = tid & 63, wr = wid >> 2, wc = wid & 3, fr = lane & 15, fq = lane >> 4;
    const int K = g.K, nt = K / BK;
    unsigned voffA[2], voffB[2];
#pragma unroll
    for (int i = 0; i < 2; ++i) { int R, C; stage_rc(tid * 16 + i * 8192, R, C); const int Rb = Epi::PERM ? ((R & ~31) + perm32(R & 31)) : R;
        voffA[i] = (unsigned)(R * K + C) * 2u; voffB[i] = (unsigned)(Rb * K + C) * 2u; }
    const size_t kstep = (size_t)(BK * 2);
    const size_t hstep = (size_t)HALF * K * 2;
    const size_t tstep = 2 * hstep;
    const unsigned ldsw = (unsigned)wid * 1024u;
    const int aoff = lds_byte(wr * 64 + fr, fq * 8), boff = lds_byte(wc * 32 + fr, fq * 8);
#define PG8_SA(b, h) (((b) * 2 + (h)) * HTB)
#define PG8_SB(b, h) ((4 + (b) * 2 + (h)) * HTB)
#define PG8_STAGE(bufoff, gbase, voff) do { _Pragma("unroll") for (int _i = 0; _i < 2; ++_i) \
        __builtin_amdgcn_global_load_lds((const unsigned*)((const char*)(gbase) + (voff)[_i]), (PG8_LAS unsigned*)(lds + (bufoff) + ldsw + _i * 8192), 16, 0, 0); } while (0)
#define PG8_LDA(dst, b, h) do { _Pragma("unroll") for (int m = 0; m < 4; ++m) _Pragma("unroll") for (int k = 0; k < 2; ++k) dst[m][k] = *(const PG8_LAS bf16x8*)(lds + PG8_SA(b, h) + aoff + m * 2048 + k * 1024); } while (0)
#define PG8_LDB(dst, b, h) do { _Pragma("unroll") for (int n = 0; n < 2; ++n) _Pragma("unroll") for (int k = 0; k < 2; ++k) dst[n][k] = *(const PG8_LAS bf16x8*)(lds + PG8_SB(b, h) + boff + n * 2048 + k * 1024); } while (0)
#define PG8_MMA(ai, bj, At, Bt) do { __builtin_amdgcn_s_setprio(1); _Pragma("unroll") for (int m = 0; m < 4; ++m) _Pragma("unroll") for (int n = 0; n < 2; ++n) _Pragma("unroll") for (int k = 0; k < 2; ++k) \
        acc[ai][bj][m][n] = __builtin_amdgcn_mfma_f32_16x16x32_bf16(Bt[n][k], At[m][k], acc[ai][bj][m][n], 0, 0, 0); __builtin_amdgcn_s_setprio(0); } while (0)
#define PG8_WAIT_V(n) asm volatile("s_waitcnt vmcnt(" #n ")" ::: "memory")
#define PG8_WAIT_L(n) asm volatile("s_waitcnt lgkmcnt(" #n ")" ::: "memory")
#define PG8_BAR __builtin_amdgcn_s_barrier()
#define PG8_SCHED __builtin_amdgcn_sched_barrier(0)
    Unit cur, nxt; int ui = 0;
    if (!S.next(0, cur)) return;
    f32x4 acc[2][2][4][2];
#pragma unroll
    for (int a = 0; a < 2; ++a)
#pragma unroll
        for (int b = 0; b < 2; ++b)
#pragma unroll
            for (int m = 0; m < 4; ++m)
#pragma unroll
                for (int n = 0; n < 2; ++n) acc[a][b][m][n] = (f32x4){0.f, 0.f, 0.f, 0.f};
    bf16x8 At[4][2], B0[2][2], B1[2][2];
    const char* cA = (const char*)g.A + (size_t)cur.pm * tstep; const char* cB = (const char*)g.Bt + (size_t)cur.pn * tstep;
    S.a_ready(cur);
    if constexpr (SP2) {
        PG8_STAGE(PG8_SB(0, 0), cB, voffB); PG8_STAGE(PG8_SB(0, 1), cB + hstep, voffB); PG8_STAGE(PG8_SA(0, 0), cA, voffA); PG8_STAGE(PG8_SA(0, 1), cA + hstep, voffA);
        if (wr == 1) PG8_BAR;
        PG8_WAIT_V(2); PG8_BAR;
        PG8_STAGE(PG8_SB(1, 0), cB + kstep, voffB); PG8_STAGE(PG8_SA(1, 0), cA + kstep, voffA); PG8_STAGE(PG8_SB(1, 1), cB + hstep + kstep, voffB);
        PG8_WAIT_V(6); PG8_BAR;
    } else {
        PG8_STAGE(PG8_SB(0, 0), cB, voffB); PG8_STAGE(PG8_SA(0, 0), cA, voffA); PG8_STAGE(PG8_SB(0, 1), cB + hstep, voffB); PG8_STAGE(PG8_SA(0, 1), cA + hstep, voffA);
        if (wr == 1) PG8_BAR;
        PG8_WAIT_V(4); PG8_BAR;
        PG8_STAGE(PG8_SB(1, 0), cB + kstep, voffB); PG8_STAGE(PG8_SA(1, 0), cA + kstep, voffA); PG8_STAGE(PG8_SB(1, 1), cB + hstep + kstep, voffB);
        PG8_WAIT_V(6); PG8_BAR;
    }
    for (;;) {
        const bool has_next = S.next(ui + 1, nxt);
        const char* nA = has_next ? (const char*)g.A + (size_t)nxt.pm * tstep : cA; const char* nB = has_next ? (const char*)g.Bt + (size_t)nxt.pn * tstep : cB;
        for (int t = 0; t < nt; t += 2) {
            const bool last = (t == nt - 2);
            const char* a1 = cA + (size_t)(t + 1) * kstep;
            const char* a2 = last ? nA : cA + (size_t)(t + 2) * kstep; const char* b2 = last ? nB : cB + (size_t)(t + 2) * kstep;
            const char* a3 = a2 + kstep; const char* b3 = b2 + kstep;
            if (last && has_next) S.a_ready(nxt);
            if constexpr (SP2) {
            PG8_LDB(B0, 0, 0); PG8_LDB(B1, 0, 1); PG8_SCHED; PG8_LDA(At, 0, 0); PG8_STAGE(PG8_SA(1, 1), a1 + hstep, voffA);
            PG8_WAIT_V(8); PG8_WAIT_L(0); PG8_BAR; PG8_MMA(0, 0, At, B0); PG8_MMA(0, 1, At, B1); PG8_BAR; PG8_SCHED;
            PG8_LDA(At, 0, 1); PG8_STAGE(PG8_SB(0, 0), b2, voffB); PG8_STAGE(PG8_SB(0, 1), b2 + hstep, voffB); PG8_STAGE(PG8_SA(0, 0), a2, voffA);
            PG8_WAIT_V(8); PG8_WAIT_L(0); PG8_BAR; PG8_MMA(1, 0, At, B0); PG8_MMA(1, 1, At, B1); PG8_BAR; PG8_SCHED;
            PG8_LDB(B0, 1, 0); PG8_LDB(B1, 1, 1); PG8_SCHED; PG8_LDA(At, 1, 0); PG8_STAGE(PG8_SA(0, 1), a2 + hstep, voffA);
            PG8_WAIT_V(8); PG8_WAIT_L(0); PG8_BAR; PG8_MMA(0, 0, At, B0); PG8_MMA(0, 1, At, B1); PG8_BAR; PG8_SCHED;
            PG8_LDA(At, 1, 1); PG8_STAGE(PG8_SB(1, 0), b3, voffB); PG8_STAGE(PG8_SB(1, 1), b3 + hstep, voffB); PG8_STAGE(PG8_SA(1, 0), a3, voffA);
            PG8_WAIT_V(8); PG8_WAIT_L(0); PG8_BAR; PG8_MMA(1, 0, At, B0); PG8_MMA(1, 1, At, B1); PG8_BAR; PG8_SCHED;
            } else {
            PG8_LDB(B0, 0, 0); PG8_SCHED; PG8_LDA(At, 0, 0); PG8_STAGE(PG8_SA(1, 1), a1 + hstep, voffA);
            PG8_WAIT_L(8); PG8_BAR; PG8_WAIT_L(0); PG8_MMA(0, 0, At, B0); PG8_BAR; PG8_SCHED;
            PG8_LDB(B1, 0, 1); PG8_STAGE(PG8_SB(0, 0), b2, voffB);
            PG8_BAR; PG8_WAIT_L(0); PG8_MMA(0, 1, At, B1); PG8_BAR;
            PG8_LDA(At, 0, 1); PG8_STAGE(PG8_SA(0, 0), a2, voffA);
            PG8_BAR; PG8_WAIT_L(0); PG8_MMA(1, 0, At, B0); PG8_BAR; PG8_SCHED;
            PG8_STAGE(PG8_SB(0, 1), b2 + hstep, voffB);
            PG8_WAIT_V(6); PG8_BAR; PG8_MMA(1, 1, At, B1); PG8_BAR;
            PG8_LDB(B0, 1, 0); PG8_SCHED; PG8_LDA(At, 1, 0); PG8_STAGE(PG8_SA(0, 1), a2 + hstep, voffA);
            PG8_WAIT_L(8); PG8_BAR; PG8_WAIT_L(0); PG8_MMA(0, 0, At, B0); PG8_BAR; PG8_SCHED;
            PG8_LDB(B1, 1, 1); PG8_STAGE(PG8_SB(1, 0), b3, voffB);
            PG8_BAR; PG8_WAIT_L(0); PG8_MMA(0, 1, At, B1); PG8_BAR;
            PG8_LDA(At, 1, 1); PG8_STAGE(PG8_SA(1, 0), a3, voffA);
            PG8_BAR; PG8_WAIT_L(0); PG8_MMA(1, 0, At, B0); PG8_BAR; PG8_SCHED;
            PG8_STAGE(PG8_SB(1, 1), b3 + hstep, voffB);
            PG8_WAIT_V(6); PG8_BAR; PG8_MMA(1, 1, At, B1); PG8_BAR;
            }
        }
        if constexpr (ALIGN_EPI) { if (wr == 0) PG8_BAR; }
        if constexpr (!Epi::AFTER_DRAIN) { E(acc, cur, wr, wc, fr, fq); S.done(cur); }
        if (!has_next) break;
#pragma unroll
        for (int a = 0; a < 2; ++a)
#pragma unroll
            for (int b = 0; b < 2; ++b)
#pragma unroll
                for (int m = 0; m < 4; ++m)
#pragma unroll
                    for (int n = 0; n < 2; ++n) acc[a][b][m][n] = (f32x4){0.f, 0.f, 0.f, 0.f};
        cur = nxt; cA = nA; cB = nB; ++ui;
        if constexpr (ALIGN_EPI) { if (wr == 1) PG8_BAR; }
    }
    PG8_WAIT_V(0);
    if constexpr (!ALIGN_EPI) { if (wr == 0) PG8_BAR; }
    PG8_BAR;
    if constexpr (Epi::AFTER_DRAIN) { E.fused(acc, cur, wr, wc, fr, fq, lds, wid, lane); S.done(cur); }
#undef PG8_SA
#undef PG8_SB
#undef PG8_STAGE
#undef PG8_LDA
#undef PG8_LDB
#undef PG8_MMA
#undef PG8_WAIT_V
#undef PG8_WAIT_L
#undef PG8_BAR
#undef PG8_SCHED
}
}

constexpr size_t MiB = 1u << 20;
constexpr size_t WS_CTL = 0, CTL_ZERO_BYTES = 1 * MiB;
constexpr size_t WS_ROPE = 1 * MiB;
constexpr size_t WS_LB = 2 * MiB;
constexpr size_t WS_WATTIN = 4 * MiB;
constexpr size_t WS_WATTOUT = 76 * MiB;
constexpr size_t WS_WRECIN = 84 * MiB;
constexpr size_t WS_WRECOUT = 148 * MiB;
constexpr size_t WS_WFF1 = 164 * MiB;
constexpr size_t WS_WFF2 = 292 * MiB;
constexpr size_t WS_XN = 420 * MiB;
constexpr size_t WS_BIG = 452 * MiB;
constexpr size_t WS_Y = 612 * MiB;
constexpr size_t WS_AUX = 676 * MiB;
constexpr size_t WS_OB = 836 * MiB;
constexpr size_t WS_END = 868 * MiB;
constexpr size_t AUX_OG = 0, AUX_LSE = 96 * MiB;
constexpr size_t AUX_HO = 0;

constexpr int NWAVES = 8;
constexpr int RING_BYTES = 131072;
constexpr int LDSCTL_OFF = RING_BYTES, MISC_OFF = LDSCTL_OFF + 320;
constexpr int LDS_BYTES = 147456;
constexpr int CW_TMO = 0, CW_CODE = 1, CW_BAR = 4096;

#define GAS __attribute__((address_space(1)))
#define LAS __attribute__((address_space(3)))
typedef unsigned short bf16;
typedef unsigned v4u __attribute__((ext_vector_type(4)));
typedef float f32x4 __attribute__((ext_vector_type(4)));
typedef short bf16x8 __attribute__((ext_vector_type(8)));
typedef GAS unsigned gu32;
typedef GAS unsigned long long gu64;
#define RLX_AGENT __ATOMIC_RELAXED, __HIP_MEMORY_SCOPE_AGENT
#define LDS_WAIT() asm volatile("s_waitcnt lgkmcnt(0)" ::: "memory")
#define VM_WAIT() asm volatile("s_waitcnt vmcnt(0)" ::: "memory")
__device__ __forceinline__ unsigned long long rt() { return __builtin_amdgcn_s_memrealtime(); }
__device__ __forceinline__ unsigned f2bf(float f) { unsigned u = __builtin_bit_cast(unsigned, f); return (u + 0x7fffu + ((u >> 16) & 1u)) >> 16; }
__device__ __forceinline__ unsigned pk2(float lo, float hi) { return f2bf(lo) | (f2bf(hi) << 16); }

#define XB_TMO      128
#define XB_XCNT(j)  (256  + 64 * (j))
#define XB_XSUB(j)  (1280 + 64 * (j))
#define XB_XGEN(j)  (2304 + 64 * (j))
#define XB_TOP      3328
#define XB_TOPGEN   3392
#define XCD_BAR_WORDS 3456
#define XB_SPIN_CAP (1u << 18)

__device__ __forceinline__ unsigned xb_ld(unsigned* p)              { return __hip_atomic_load(p, __ATOMIC_RELAXED, __HIP_MEMORY_SCOPE_AGENT); }
__device__ __forceinline__ unsigned xb_add(unsigned* p, unsigned v) { return __hip_atomic_fetch_add(p, v, __ATOMIC_RELAXED, __HIP_MEMORY_SCOPE_AGENT); }
__device__ __forceinline__ unsigned xb_xcc_id() { return (unsigned)__builtin_amdgcn_s_getreg((3 << 11) | 20) & 0xFu; }
#define XB_SPIN(cond, bar) do { unsigned _sp = 0; while (cond) { __builtin_amdgcn_s_sleep(1); \
    if ((++_sp & 255u) == 0u) { if (xb_ld(&(bar)[XB_TMO])) break; if (_sp > XB_SPIN_CAP) { atomicAdd(&(bar)[XB_TMO], 1u); break; } } } } while (0)

struct XcdBarrier {
    unsigned* bar; unsigned x;
    volatile LAS unsigned* st;
};

__device__ __forceinline__ XcdBarrier xcd_barrier_post(unsigned* bar, volatile LAS unsigned* st) {
    XcdBarrier b; b.bar = bar; b.x = xb_xcc_id(); b.st = st;
    if (threadIdx.x == 0) (void)xb_add(&bar[XB_XCNT(b.x)], 1u);
    return b;
}
__device__ __forceinline__ void xcd_barrier_complete(unsigned* bar, unsigned x, unsigned& nloc, unsigned& nx) {
    const unsigned G = gridDim.x * gridDim.y * gridDim.z;
    unsigned sum, cnt, mine, sp = 0u;
    for (;;) {
        sum = 0u; cnt = 0u; mine = 0u;
#pragma unroll
        for (unsigned j = 0; j < 16; ++j) { const unsigned c = xb_ld(&bar[XB_XCNT(j)]); sum += c; cnt += (c > 0u) ? 1u : 0u; mine = (j == x) ? c : mine; }
        if (sum == G) break;
        __builtin_amdgcn_s_sleep(1);
        if ((++sp & 255u) == 0u) { if (xb_ld(&bar[XB_TMO])) break; if (sp > XB_SPIN_CAP) { atomicAdd(&bar[XB_TMO], 1u); break; } }
    }
    nloc = mine > 0u ? mine : 1u; nx = cnt > 0u ? cnt : 1u;
}

__device__ __forceinline__ void xcd_barrier(const XcdBarrier& b) {
    asm volatile("s_waitcnt vmcnt(0)" ::: "memory");
    __syncthreads();
    if (threadIdx.x == 0) {
        unsigned* bar = b.bar;
        __builtin_amdgcn_s_waitcnt(0);
        unsigned nloc = b.st[0], nx = b.st[1];
        if (nloc == 0u) { xcd_barrier_complete(bar, b.x, nloc, nx); b.st[0] = nloc; b.st[1] = nx; }
        const unsigned old = xb_add(&bar[XB_XSUB(b.x)], 1u);
        const unsigned gen = old / nloc;
        if (old + 1u == (gen + 1u) * nloc) {
            __builtin_amdgcn_fence(__ATOMIC_RELEASE, "agent");
            asm volatile("s_waitcnt vmcnt(0)" ::: "memory");
            const unsigned og = xb_add(&bar[XB_TOP], 1u);
            const unsigned tg = og / nx;
            if (og + 1u == (tg + 1u) * nx) xb_add(&bar[XB_TOPGEN], 1u);
            else XB_SPIN(xb_ld(&bar[XB_TOPGEN]) == tg, bar);
            __builtin_amdgcn_fence(__ATOMIC_ACQUIRE, "agent");
            xb_add(&bar[XB_XGEN(b.x)], 1u);
            asm volatile("s_waitcnt vmcnt(0)" ::: "memory");
        } else {
            XB_SPIN(xb_ld(&bar[XB_XGEN(b.x)]) == gen, bar);
            __builtin_amdgcn_fence(__ATOMIC_ACQUIRE, "agent");
            asm volatile("s_waitcnt vmcnt(0)" ::: "memory");
        }
    }
    __syncthreads();
}


struct Frame {
    LAS unsigned char* lds;
    volatile LAS unsigned* MISC;
    gu32* ctl;
    int tid, lane, wave;
    int vcu, G;
};
__device__ __forceinline__ float wave_sum(float v) {
#pragma unroll
    for (int o = 1; o < 64; o <<= 1) v += __shfl_xor(v, o);
    return v;
}
__device__ __forceinline__ float wave_max(float v) {
#pragma unroll
    for (int o = 1; o < 64; o <<= 1) v = fmaxf(v, __shfl_xor(v, o));
    return v;
}
__device__ __forceinline__ float bf2f(unsigned short b) { return __builtin_bit_cast(float, ((unsigned)b) << 16); }
__device__ __forceinline__ float bflo(unsigned w) { return __builtin_bit_cast(float, w << 16); }
__device__ __forceinline__ float bfhi(unsigned w) { return __builtin_bit_cast(float, w & 0xffff0000u); }

__host__ __device__ __forceinline__ int rec_phys_row(int n) { const int type = n >> 11, h = (n & 2047) >> 7, c = n & 127; return 512 * h + 128 * type + c; }

template <bool RECPERM>
__device__ __forceinline__ void p0_transpose_item(const float* __restrict__ W, int K, int N, bf16* __restrict__ WT, LAS unsigned* scr, int item, int lane) {
    const int nblk = N / 64, kb = item / nblk, nb = item % nblk, k0 = 64 * kb, n0 = 64 * nb;
    const int c4 = lane & 15, kr = lane >> 4;
#pragma unroll
    for (int i = 0; i < 8; ++i) {
        const int k = k0 + 8 * i + 2 * kr;
        const f32x4 a = *(const f32x4*)(W + (size_t)k * N + n0 + 4 * c4);
        const f32x4 b = *(const f32x4*)(W + (size_t)(k + 1) * N + n0 + 4 * c4);
#pragma unroll
        for (int j = 0; j < 4; ++j) scr[(4 * c4 + j) * 33 + 4 * i + kr] = pk2(a[j], b[j]);
    }
    LDS_WAIT(); asm volatile("" ::: "memory");
    const int np0 = RECPERM ? rec_phys_row(n0) : n0;
#pragma unroll
    for (int i2 = 0; i2 < 8; ++i2) {
        const int n = 8 * i2 + (lane >> 3), kc = lane & 7;
        v4u o; o.x = scr[n * 33 + 4 * kc + 0]; o.y = scr[n * 33 + 4 * kc + 1]; o.z = scr[n * 33 + 4 * kc + 2]; o.w = scr[n * 33 + 4 * kc + 3];
        *(v4u*)(WT + (size_t)(np0 + n) * K + k0 + 8 * kc) = o;
    }
    LDS_WAIT(); asm volatile("" ::: "memory");
}
template <bool RECPERM>
__device__ __forceinline__ void p0_transpose(Frame& F, const float* W, int K, int N, bf16* WT, int nmat) {
    LAS unsigned* scr = (LAS unsigned*)(F.lds + F.wave * 16384);
    const int gw = F.vcu * NWAVES + F.wave, NGW = F.G * NWAVES;
    const int per = (K / 64) * (N / 64), total = per * nmat;
    for (int it = gw; it < total; it += NGW) {
        const int mi = it / per, r = it % per;
        p0_transpose_item<RECPERM>(W + (size_t)mi * K * N, K, N, WT + (size_t)mi * K * N, scr, r, F.lane);
    }
}

__device__ const double kInvFreq[16] = {1.0, 0.44036660267178046, 0.19392274474868576, 0.08539710028576561, 0.03760603093086393, 0.016560440080994446, 0.007292664737217109, 0.003211445994752591,
    0.001414213562373095, 0.000622772421914596, 0.0002742481756762073, 0.00012076973741146504, 5.318295896944988e-05, 2.341999896140934e-05, 1.031338537721246e-05, 4.5416704806078695e-06};
__device__ __forceinline__ void p0_tables(Frame& F, const int* positions, const float* rlb, float* cs, float* sn, float* lbt) {
    const int gt = F.vcu * NWAVES * 64 + F.tid, NT = F.G * NWAVES * 64;
    for (int i = gt; i < M * 16; i += NT) {
        const int m = i >> 4, f = i & 15;
        const double invf = kInvFreq[f];
        double ang = (double)positions[m] * invf;
        ang -= 6.283185307179586476925 * (double)__builtin_rint(ang * 0.15915494309189533577);
        const float ar = (float)ang;
        cs[i] = cosf(ar); sn[i] = sinf(ar);
    }
    for (int c = gt; c < 2048; c += NT) {
        const float r0 = rlb[c], r1 = rlb[2048 + c];
        const float mx = fmaxf(r0, r1), e0 = expf(r0 - mx), e1 = expf(r1 - mx);
        const float lb1 = e1 / (e0 + e1);
        lbt[0 * 4096 + c] = 1e-30f;            lbt[0 * 4096 + 2048 + c] = 1.0f;
        lbt[1 * 4096 + c] = fmaxf(lb1, 1e-30f); lbt[1 * 4096 + 2048 + c] = 1.0f - lb1;
    }
}

__device__ __forceinline__ void phase_thin(Frame& F, const float* Y, const float* hin, float* hout, const float* gpost, const float* gpre, bf16* XN) {
    const int gw = F.vcu * NWAVES + F.wave, NGW = F.G * NWAVES;
    for (int m = gw; m < M; m += NGW) {
        const f32x4* hr = (const f32x4*)(hin + (size_t)m * D) + F.lane;
        f32x4 hv[8];
#pragma unroll
        for (int j = 0; j < 8; ++j) hv[j] = hr[64 * j];
        if (Y) {
            const f32x4* yr = (const f32x4*)(Y + (size_t)m * D) + F.lane;
            f32x4 yv[8]; float ss = 0.f;
#pragma unroll
            for (int j = 0; j < 8; ++j) { yv[j] = yr[64 * j]; ss += (yv[j].x * yv[j].x + yv[j].y * yv[j].y) + (yv[j].z * yv[j].z + yv[j].w * yv[j].w); }
            const float r1 = 1.0f / sqrtf(wave_sum(ss) * (1.0f / D) + NORM_EPS);
#pragma unroll
            for (int j = 0; j < 8; ++j) { const f32x4 g = ((const f32x4*)gpost)[F.lane + 64 * j]; hv[j] = hv[j] + yv[j] * r1 * g; }
        }
        f32x4* ho = (f32x4*)(hout + (size_t)m * D) + F.lane;
#pragma unroll
        for (int j = 0; j < 8; ++j) ho[64 * j] = hv[j];
        if (XN) {
            float s2 = 0.f;
#pragma unroll
            for (int j = 0; j < 8; ++j) s2 += (hv[j].x * hv[j].x + hv[j].y * hv[j].y) + (hv[j].z * hv[j].z + hv[j].w * hv[j].w);
            const float r2 = 1.0f / sqrtf(wave_sum(s2) * (1.0f / D) + NORM_EPS);
            unsigned long long* o8 = (unsigned long long*)(XN + (size_t)m * D) + F.lane;
#pragma unroll
            for (int j = 0; j < 8; ++j) { const f32x4 g = ((const f32x4*)gpre)[F.lane + 64 * j]; const f32x4 o = hv[j] * r2 * g;
                o8[64 * j] = (unsigned long long)pk2(o.x, o.y) | ((unsigned long long)pk2(o.z, o.w) << 32); }
        }
    }
}

__device__ __forceinline__ float dot128_bf16(const bf16* a, const bf16* b) {
    float s = 0.f;
#pragma unroll
    for (int i = 0; i < 16; ++i) { const v4u x = *(const v4u*)(a + 8 * i), y = *(const v4u*)(b + 8 * i);
        s += bflo(x.x) * bflo(y.x) + bfhi(x.x) * bfhi(y.x) + bflo(x.y) * bflo(y.y) + bfhi(x.y) * bfhi(y.y)
           + bflo(x.z) * bflo(y.z) + bfhi(x.z) * bfhi(y.z) + bflo(x.w) * bflo(y.w) + bfhi(x.w) * bfhi(y.w); }
    return s;
}
__device__ __forceinline__ void phase_attn_naive(Frame& F, const bf16* QKV, float* og, float* lse) {
    const int gw = F.vcu * NWAVES + F.wave, NGW = F.G * NWAVES, lane = F.lane;
    for (int task = gw; task < M * 24; task += NGW) {
        const int m = task / 24, gh = task % 24, g = gh >> 3, h = gh & 7;
        const int b = m / SEQ, t = m % SEQ;
        const int dil = (g == 0) ? 1 : (g == 1 ? 4 : 16);
        const int p = t / dil;
        const bf16* qp = QKV + (size_t)m * ATT_IN + g * 3072 + h * HD;
        float sc[3]; bool ok[3];
#pragma unroll
        for (int kk = 0; kk < 3; ++kk) {
            const int dist = lane + 64 * kk; ok[kk] = (dist <= 128) && (dist <= p);
            sc[kk] = -3.0e38f;
            if (ok[kk]) { const int t2 = t - dist * dil; sc[kk] = dot128_bf16(qp, QKV + (size_t)(b * SEQ + t2) * ATT_IN + g * 3072 + 1024 + h * HD); }
        }
        const float mx = wave_max(fmaxf(fmaxf(sc[0], sc[1]), sc[2]));
        float pe[3]; float ls = 0.f;
#pragma unroll
        for (int kk = 0; kk < 3; ++kk) { pe[kk] = ok[kk] ? exp2f(sc[kk] - mx) : 0.f; ls += pe[kk]; }
        const float l = wave_sum(ls);
        float o0 = 0.f, o1 = 0.f;
        for (int kk = 0; kk < 3; ++kk) {
            const int nmax = (kk == 2) ? 1 : 64;
            for (int sl = 0; sl < nmax; ++sl) {
                const float pk = __shfl(pe[kk], sl);
                const int dist = sl + 64 * kk;
                if (dist <= p && dist <= 128) {
                    const int t2 = t - dist * dil;
                    const unsigned w = *(const unsigned*)(QKV + (size_t)(b * SEQ + t2) * ATT_IN + g * 3072 + 2048 + h * HD + 2 * lane);
                    o0 += pk * bflo(w); o1 += pk * bfhi(w);
                }
            }
        }
        const float inv = 1.0f / l;
        float* op = og + ((size_t)g * M + m) * ATT_OUT + h * HD + 2 * lane;
        op[0] = o0 * inv; op[1] = o1 * inv;
        if (lane == 0) lse[((size_t)g * M + m) * 8 + h] = mx + log2f(l);
    }
}
__device__ __forceinline__ void phase_combine(Frame& F, const float* og, const float* lse, bf16* OB) {
    const int gw = F.vcu * NWAVES + F.wave, NGW = F.G * NWAVES, lane = F.lane;
    for (int m = gw; m < M; m += NGW) {
        const int h = lane >> 3;
        const float l0 = lse[((size_t)0 * M + m) * 8 + h], l1 = lse[((size_t)1 * M + m) * 8 + h], l2 = lse[((size_t)2 * M + m) * 8 + h];
        const float mx = fmaxf(fmaxf(l0, l1), l2);
        float w0 = exp2f(l0 - mx), w1 = exp2f(l1 - mx), w2 = exp2f(l2 - mx);
        const float inv = 1.0f / (w0 + w1 + w2); w0 *= inv; w1 *= inv; w2 *= inv;
        const f32x4* a0 = (const f32x4*)(og + ((size_t)0 * M + m) * ATT_OUT + 16 * lane);
        const f32x4* a1 = (const f32x4*)(og + ((size_t)1 * M + m) * ATT_OUT + 16 * lane);
        const f32x4* a2 = (const f32x4*)(og + ((size_t)2 * M + m) * ATT_OUT + 16 * lane);
        unsigned wds[8];
#pragma unroll
        for (int j = 0; j < 4; ++j) { const f32x4 o = a0[j] * w0 + a1[j] * w1 + a2[j] * w2; wds[2 * j] = pk2(o.x, o.y); wds[2 * j + 1] = pk2(o.z, o.w); }
        v4u* dst = (v4u*)(OB + (size_t)m * ATT_OUT + 16 * lane);
        dst[0] = (v4u){wds[0], wds[1], wds[2], wds[3]}; dst[1] = (v4u){wds[4], wds[5], wds[6], wds[7]};
    }
}

__device__ __forceinline__ void phase_hgrn_naive(Frame& F, const bf16* P, const float* lbt  , float* ho) {
    LAS float* sq = (LAS float*)(F.lds);
    LAS float* sf = sq + 128;
    LAS float* sk = sf + 128;
    LAS float* sv = sk + 128;
    LAS float* part = sv + 128;
    const int tid = F.tid, n = tid & 127, kq = tid >> 7;
    for (int unit = F.vcu; unit < BATCH * 16; unit += F.G) {
        const int b = unit >> 4, h = unit & 15;
        float S[32];
#pragma unroll
        for (int i = 0; i < 32; ++i) S[i] = 0.f;
        for (int t = 0; t < SEQ; ++t) {
            const bf16* row = P + (size_t)(b * SEQ + t) * REC_IN + 512 * h;
            if (tid < 128) {
                const float q = bf2f(row[tid]), z = bf2f(row[128 + tid]), v = bf2f(row[256 + tid]);
                const float lbc = lbt[h * 128 + tid], oml = lbt[2048 + h * 128 + tid];
                const float s = 1.0f / (1.0f + expf(-z));
                sq[tid] = q; sf[tid] = lbc + oml * s; sk[tid] = oml * (1.0f - s); sv[tid] = v;
            }
            __syncthreads();
            const float v = sv[n]; float acc = 0.f;
#pragma unroll
            for (int i = 0; i < 32; ++i) { const int k = kq * 32 + i; S[i] = sf[k] * S[i] + sk[k] * v; acc += sq[k] * S[i]; }
            part[kq * 128 + n] = acc;
            __syncthreads();
            if (tid < 128) ho[(size_t)(b * SEQ + t) * D + h * 128 + tid] = (part[tid] + part[128 + tid]) + (part[256 + tid] + part[384 + tid]);
        }
        __syncthreads();
    }
}
__device__ __forceinline__ void phase_normgate(Frame& F, const float* ho, const bf16* P, const float* gnorm, bf16* OB) {
    const int gw = F.vcu * NWAVES + F.wave, NGW = F.G * NWAVES, lane = F.lane;
    const f32x4 gn = *(const f32x4*)(gnorm + 4 * (lane & 31));
    for (int m = gw; m < M; m += NGW) {
        const f32x4* orow = (const f32x4*)(ho + (size_t)m * D) + lane;
        unsigned long long* o8 = (unsigned long long*)(OB + (size_t)m * D) + lane;
#pragma unroll
        for (int j = 0; j < 8; ++j) {
            const f32x4 v = orow[64 * j];
            float ss = (v.x * v.x + v.y * v.y) + (v.z * v.z + v.w * v.w);
#pragma unroll
            for (int o = 1; o < 32; o <<= 1) ss += __shfl_xor(ss, o);
            const float r = 1.0f / sqrtf(ss * (1.0f / 128.0f) + NORM_EPS);
            const int h = 2 * j + (lane >> 5);
            const unsigned long long gw8 = *(const unsigned long long*)(P + (size_t)m * REC_IN + 512 * h + 384 + 4 * (lane & 31));
            const unsigned glo = (unsigned)gw8, ghi = (unsigned)(gw8 >> 32);
            const float g0 = bflo(glo), g1 = bfhi(glo), g2 = bflo(ghi), g3 = bfhi(ghi);
            const float s0 = g0 / (1.0f + expf(-g0)), s1 = g1 / (1.0f + expf(-g1)), s2 = g2 / (1.0f + expf(-g2)), s3 = g3 / (1.0f + expf(-g3));
            o8[64 * j] = (unsigned long long)pk2(v.x * r * gn.x * s0, v.y * r * gn.y * s1) | ((unsigned long long)pk2(v.z * r * gn.z * s2, v.w * r * gn.w * s3) << 32);
        }
    }
}


struct Args { const float* in[11]; float* out; unsigned char* ws; };

__device__ __forceinline__ void frame_refresh(Frame& F) {
    int t = threadIdx.x; asm volatile("" : "+v"(t)); F.tid = t; F.lane = t & 63; F.wave = __builtin_amdgcn_readfirstlane(t >> 6);
}
__device__ __forceinline__ void frame_init(Frame& F, unsigned char* lds, unsigned char* ws) {
    F.lds = (LAS unsigned char*)lds;
    F.MISC = (volatile LAS unsigned*)(F.lds + MISC_OFF);
    F.tid = threadIdx.x; F.lane = F.tid & 63; F.wave = __builtin_amdgcn_readfirstlane(F.tid >> 6);
    F.G = gridDim.x; { const int bx = blockIdx.x; F.vcu = (F.G % 8 == 0) ? (bx % 8) * (F.G / 8) + bx / 8 : bx; }
    F.ctl = (gu32*)(ws + WS_CTL);
}


__global__ void __launch_bounds__(NWAVES * 64, 2) mega_fwd(Args args) {
    extern __shared__ __attribute__((aligned(16))) unsigned char lds[];
    Frame F; frame_init(F, lds, args.ws);
    unsigned char* ws = args.ws;
    const float* x = args.in[0]; const int* positions = (const int*)args.in[1]; const float* gains = args.in[2];
    const float* w_att_in = args.in[3]; const float* w_att_out = args.in[4]; const float* w_rec_in = args.in[5];
    const float* rlb = args.in[6]; const float* rec_norm = args.in[7]; const float* w_rec_out = args.in[8];
    const float* w_ff1 = args.in[9]; const float* w_ff2 = args.in[10];
    float* hbuf = args.out;
    bf16* XN = (bf16*)(ws + WS_XN); bf16* BIG = (bf16*)(ws + WS_BIG); float* Y = (float*)(ws + WS_Y); bf16* OB = (bf16*)(ws + WS_OB);
    float* cs = (float*)(ws + WS_ROPE); float* sn = cs + M * 16; float* lbt = (float*)(ws + WS_LB);
    for (int u = F.tid; u < (LDS_BYTES - LDSCTL_OFF) / 4; u += NWAVES * 64) ((LAS unsigned*)(F.lds + LDSCTL_OFF))[u] = 0u;
    __syncthreads();
    XcdBarrier bar = xcd_barrier_post((unsigned*)(F.ctl + CW_BAR), F.MISC + 8);
#define GRID_BAR() xcd_barrier(bar)

    p0_transpose<false>(F, w_att_in, D, ATT_IN, (bf16*)(ws + WS_WATTIN), 2);
    p0_transpose<false>(F, w_att_out, ATT_OUT, D, (bf16*)(ws + WS_WATTOUT), 2);
    p0_transpose<true>(F, w_rec_in, D, REC_IN, (bf16*)(ws + WS_WRECIN), 2);
    p0_transpose<false>(F, w_rec_out, D, D, (bf16*)(ws + WS_WRECOUT), 2);
    p0_transpose<false>(F, w_ff1, D, DFF, (bf16*)(ws + WS_WFF1), 4);
    p0_transpose<false>(F, w_ff2, DFF, D, (bf16*)(ws + WS_WFF2), 4);
    p0_tables(F, positions, rlb, cs, sn, lbt);
    phase_thin(F, nullptr, x, hbuf, nullptr, gains, XN);
    GRID_BAR();

    for (int layer = 0; layer < DEPTH; ++layer) {
        const int j = layer >> 1;
        const float* g = gains + (size_t)layer * 4 * D;
        if ((layer & 1) == 0) {
            {   pg8::Gemm gm{XN, (const bf16*)(ws + WS_WATTIN) + (size_t)j * ATT_IN * D, M, ATT_IN, D}; pg8::StaticOrder S; S.init(M, ATT_IN, F.G, (int)blockIdx.x);
                pg8::EpiQKV E{BIG, ATT_IN, cs, sn, QSCALE};
                pg8::gemm_phase<pg8::EpiQKV, pg8::StaticOrder, true, true>(F.lds, gm, S, E); }
            GRID_BAR();
            frame_refresh(F); phase_attn_naive(F, BIG, (float*)(ws + WS_AUX + AUX_OG), (float*)(ws + WS_AUX + AUX_LSE));
            GRID_BAR();
            frame_refresh(F); phase_combine(F, (const float*)(ws + WS_AUX + AUX_OG), (const float*)(ws + WS_AUX + AUX_LSE), OB);
            GRID_BAR();
            {   pg8::Gemm gm{OB, (const bf16*)(ws + WS_WATTOUT) + (size_t)j * D * ATT_OUT, M, D, ATT_OUT}; pg8::StaticOrder S; S.init(M, D, F.G, (int)blockIdx.x);
                pg8::EpiF32 E{Y, D};
                pg8::gemm_phase<pg8::EpiF32, pg8::StaticOrder, true, true>(F.lds, gm, S, E); }
            GRID_BAR();
        } else {
            {   pg8::Gemm gm{XN, (const bf16*)(ws + WS_WRECIN) + (size_t)j * REC_IN * D, M, REC_IN, D}; pg8::StaticOrder S; S.init(M, REC_IN, F.G, (int)blockIdx.x);
                pg8::EpiBf16<0> E{BIG, REC_IN};
                pg8::gemm_phase<pg8::EpiBf16<0>, pg8::StaticOrder, true, true>(F.lds, gm, S, E); }
            GRID_BAR();
            frame_refresh(F); phase_hgrn_naive(F, BIG, lbt + (size_t)j * 4096, (float*)(ws + WS_AUX + AUX_HO));
            GRID_BAR();
            frame_refresh(F); phase_normgate(F, (const float*)(ws + WS_AUX + AUX_HO), BIG, rec_norm + (size_t)j * HD, OB);
            GRID_BAR();
            {   pg8::Gemm gm{OB, (const bf16*)(ws + WS_WRECOUT) + (size_t)j * D * D, M, D, D}; pg8::StaticOrder S; S.init(M, D, F.G, (int)blockIdx.x);
                pg8::EpiF32 E{Y, D};
                pg8::gemm_phase<pg8::EpiF32, pg8::StaticOrder, true, true>(F.lds, gm, S, E); }
            GRID_BAR();
        }
        frame_refresh(F); phase_thin(F, Y, hbuf, hbuf, g + D, g + 2 * D, XN);
        GRID_BAR();
        {   pg8::Gemm gm{XN, (const bf16*)(ws + WS_WFF1) + (size_t)layer * DFF * D, M, DFF, D}; pg8::StaticOrder S; S.init(M, DFF, F.G, (int)blockIdx.x);
            pg8::EpiBf16<1> E{BIG, DFF};
            pg8::gemm_phase<pg8::EpiBf16<1>, pg8::StaticOrder, true, true>(F.lds, gm, S, E); }
        GRID_BAR();
        {   pg8::Gemm gm{BIG, (const bf16*)(ws + WS_WFF2) + (size_t)layer * D * DFF, M, D, DFF}; pg8::StaticOrder S; S.init(M, D, F.G, (int)blockIdx.x);
            pg8::EpiF32 E{Y, D};
            pg8::gemm_phase<pg8::EpiF32, pg8::StaticOrder, true, true>(F.lds, gm, S, E); }
        GRID_BAR();
        {   const bool last = (layer == DEPTH - 1);
            frame_refresh(F); phase_thin(F, Y, hbuf, hbuf, g + 3 * D, last ? nullptr : (g + 4 * D), last ? nullptr : XN); }
        if (layer != DEPTH - 1) GRID_BAR();
    }
    if (xb_ld(bar.bar + XB_TMO) != 0u) {
        const int gw = F.vcu * NWAVES + F.wave, NGW = F.G * NWAVES; const float q = __builtin_nanf("");
        for (int m = gw; m < M; m += NGW) { f32x4* o = (f32x4*)(hbuf + (size_t)m * D) + F.lane;
#pragma unroll
            for (int jj = 0; jj < 8; ++jj) o[64 * jj] = (f32x4){q, q, q, q}; }
    }
#undef GRID_BAR
}

extern "C" void kernel_launch(void* const* d_in, const int* in_sizes, int n_in, void* d_out, int out_size, void* d_ws, size_t ws_size, hipStream_t stream) {
    static int grid = 0;
    if (grid == 0) {
        if (n_in != 11 || out_size != M * D || ws_size < WS_END) { fprintf(stderr, "kernel_launch: unexpected shapes (n_in %d, out %d, ws %zu)\n", n_in, out_size, ws_size); grid = -1; return; }
        int dev = 0, cus = 0, per_cu = 0;
        if (hipGetDevice(&dev) != hipSuccess || hipDeviceGetAttribute(&cus, hipDeviceAttributeMultiprocessorCount, dev) != hipSuccess) { grid = -1; return; }
        if (hipFuncSetAttribute((const void*)mega_fwd, hipFuncAttributeMaxDynamicSharedMemorySize, LDS_BYTES) != hipSuccess) { grid = -1; return; }
        if (hipOccupancyMaxActiveBlocksPerMultiprocessor(&per_cu, (const void*)mega_fwd, NWAVES * 64, LDS_BYTES) != hipSuccess || per_cu < 1)
            fprintf(stderr, "kernel_launch: note: occupancy query reports %d workgroups per CU\n", per_cu);
        (void)hipGetLastError();
        grid = cus;
    }
    if (grid < 0) return;
    (void)hipMemsetAsync((char*)d_ws + WS_CTL, 0, CTL_ZERO_BYTES, stream);
    Args a{};
    for (int i = 0; i < 11; ++i) a.in[i] = (const float*)d_in[i];
    a.out = (float*)d_out; a.ws = (unsigned char*)d_ws;
    hipLaunchKernelGGL(mega_fwd, dim3(grid), dim3(NWAVES * 64), LDS_BYTES, stream, a);
}
```

```cpp
#include <hip/hip_runtime.h>
#include <cstdio>
#include <cstdint>

constexpr int BATCH = 4, SEQ = 2048, D = 2048, DEPTH = 4;
constexpr int M = BATCH * SEQ;
constexpr int ATT_IN = 9216, ATT_OUT = 1024, REC_IN = 8192, DFF = 8192;
constexpr int HD = 128;
constexpr float NORM_EPS = 1e-6f;
constexpr float QSCALE = 0.08838834764831845f * 1.4426950408889634f;

namespace pg8 {
#define PG8_LAS __attribute__((address_space(3)))
typedef unsigned short bf16_t;
typedef short bf16x8 __attribute__((ext_vector_type(8)));
typedef float f32x4 __attribute__((ext_vector_type(4)));
typedef unsigned u32x4 __attribute__((ext_vector_type(4)));
constexpr int BM = 256, BK = 64, HALF = 128, HTB = HALF * BK * 2  , STAGE_BYTES = 8 * HTB, NXCD = 8, WGM = 8;

__host__ __device__ __forceinline__ int lds_byte(int r, int c) { const int st = (r >> 4) * 2 + (c >> 5), rr = r & 15, cc = c & 31, ob = rr * 64 + cc * 2; return st * 1024 + (ob ^ (((ob >> 9) & 1) << 5)); }
__host__ __device__ __forceinline__ void stage_rc(int b, int& R, int& C) { const int st = b / 1024, sb = b % 1024, swz = sb ^ (((sb >> 9) & 1) << 5); R = (st >> 1) * 16 + swz / 64; C = (st & 1) * 32 + (swz % 64) / 2; }
__host__ __device__ __forceinline__ int perm32(int rho) { const int n = rho >> 4, i = rho & 15; return 8 * (i >> 2) + 4 * n + (i & 3); }

struct Unit { int pm, pn; };
struct Gemm { const bf16_t* A; const bf16_t* Bt; int M, N, K; };

struct StaticOrder {
    int nM, nN, nwg, G, c;
    __host__ __device__ void init(int M, int N, int G_, int c_) { nM = M / BM; nN = N / BM; nwg = nM * nN; G = G_; c = c_; }
    __host__ __device__ bool next(int i, Unit& u) const {
        const long L = (long)i * G + c; if (L >= nwg) return false;
        int wgid = (int)L; { const int q = nwg / NXCD, r = nwg % NXCD, xcd = wgid % NXCD, off = wgid / NXCD; wgid = (xcd < r ? xcd * (q + 1) : r * (q + 1) + (xcd - r) * q) + off; }
        const int nig = WGM * nN, gid = wgid / nig, fm = gid * WGM, gsz = (nM - fm) < WGM ? (nM - fm) : WGM;
        u.pm = fm + ((wgid % nig) % gsz); u.pn = (wgid % nig) / gsz; return true;
    }
    __device__ __forceinline__ void a_ready(const Unit&) const {}
    __device__ __forceinline__ void done(const Unit&) const {}
};

__device__ __forceinline__ unsigned cvt_pk_bf16(float lo, float hi) { unsigned r; asm volatile("v_cvt_pk_bf16_f32 %0, %1, %2" : "=v"(r) : "v"(lo), "v"(hi)); return r; }

struct EpiF32 {
    static constexpr bool PERM = false, AFTER_DRAIN = false;
    float* C; int ldc;
    __device__ __forceinline__ void operator()(const f32x4 (&acc)[2][2][4][2], const Unit& u, int wr, int wc, int fr, int fq) const {
        const int row0 = u.pm * BM + wr * 64 + fr, col0 = u.pn * BM + wc * 32 + 4 * fq;
#pragma unroll
        for (int ai = 0; ai < 2; ++ai)
#pragma unroll
            for (int m = 0; m < 4; ++m) { float* rowp = C + (size_t)(row0 + ai * HALF + m * 16) * ldc + col0;
#pragma unroll
                for (int bj = 0; bj < 2; ++bj)
#pragma unroll
                    for (int n = 0; n < 2; ++n) *(f32x4*)(rowp + bj * HALF + n * 16) = acc[ai][bj][m][n]; }
    }
};
template <int ACT  > struct EpiBf16 {
    static constexpr bool PERM = true, AFTER_DRAIN = false;
    bf16_t* O; int ldc;
    __device__ __forceinline__ void operator()(const f32x4 (&acc)[2][2][4][2], const Unit& u, int wr, int wc, int fr, int fq) const {
        const int row0 = u.pm * BM + wr * 64 + fr, col0 = u.pn * BM + wc * 32 + 8 * fq;
#pragma unroll
        for (int ai = 0; ai < 2; ++ai)
#pragma unroll
            for (int m = 0; m < 4; ++m) { bf16_t* rowp = O + (size_t)(row0 + ai * HALF + m * 16) * ldc + col0;
#pragma unroll
                for (int bj = 0; bj < 2; ++bj) { f32x4 v0 = acc[ai][bj][m][0], v1 = acc[ai][bj][m][1];
                    if (ACT == 1) {
#pragma unroll
                        for (int j = 0; j < 4; ++j) { const float a = fmaxf(v0[j], 0.f), b = fmaxf(v1[j], 0.f); v0[j] = a * a; v1[j] = b * b; } }
                    u32x4 w; w.x = cvt_pk_bf16(v0[0], v0[1]); w.y = cvt_pk_bf16(v0[2], v0[3]); w.z = cvt_pk_bf16(v1[0], v1[1]); w.w = cvt_pk_bf16(v1[2], v1[3]);
                    *(u32x4*)(rowp + bj * HALF) = w; } }
    }
};
struct EpiQKV {
    static constexpr bool PERM = true, AFTER_DRAIN = false;
    bf16_t* O; int ldc; const float* cs; const float* sn; float qscale;
    __device__ __forceinline__ void operator()(const f32x4 (&acc)[2][2][4][2], const Unit& u, int wr, int wc, int fr, int fq) const {
        const int row0 = u.pm * BM + wr * 64 + fr, col0 = u.pn * BM + wc * 32 + 8 * fq;
        const int t = (u.pn % 12) >> 2;
        const bool rope = (t < 2) && (wc == 0);
        const float sc = (t == 0) ? qscale : 1.0f;
        const bool upper = fq >= 2;
#pragma unroll
        for (int ai = 0; ai < 2; ++ai)
#pragma unroll
            for (int m = 0; m < 4; ++m) { const int row = row0 + ai * HALF + m * 16; bf16_t* rowp = O + (size_t)row * ldc + col0;
                f32x4 c0 = {1.f, 1.f, 1.f, 1.f}, c1 = c0, s0 = {0.f, 0.f, 0.f, 0.f}, s1 = s0;
                if (rope) { const float* cp = cs + (size_t)row * 16 + 8 * (fq & 1); const float* sp = sn + (size_t)row * 16 + 8 * (fq & 1);
                    c0 = *(const f32x4*)cp; c1 = *(const f32x4*)(cp + 4); s0 = *(const f32x4*)sp; s1 = *(const f32x4*)(sp + 4); }
#pragma unroll
                for (int bj = 0; bj < 2; ++bj) { f32x4 v0 = acc[ai][bj][m][0], v1 = acc[ai][bj][m][1];
                    if (rope) {
#pragma unroll
                        for (int j = 0; j < 4; ++j) {
                            const float p0 = __shfl_xor(v0[j], 32), p1 = __shfl_xor(v1[j], 32);
                            v0[j] = upper ? (v0[j] * c0[j] + p0 * s0[j]) : (v0[j] * c0[j] - p0 * s0[j]);
                            v1[j] = upper ? (v1[j] * c1[j] + p1 * s1[j]) : (v1[j] * c1[j] - p1 * s1[j]); } }
                    v0 = v0 * sc; v1 = v1 * sc;
                    u32x4 w; w.x = cvt_pk_bf16(v0[0], v0[1]); w.y = cvt_pk_bf16(v0[2], v0[3]); w.z = cvt_pk_bf16(v1[0], v1[1]); w.w = cvt_pk_bf16(v1[2], v1[3]);
                    *(u32x4*)(rowp + bj * HALF) = w; } }
    }
};

template <class Epi, class Sched, bool ALIGN_EPI = false, bool SP2 = false>
__device__ __forceinline__ void gemm_phase(PG8_LAS unsigned char* lds, const Gemm g, const Sched& S, const Epi& E) {
    int tid_ = threadIdx.x; asm volatile("" : "+v"(tid_));
    const int tid = tid_, wid = __builtin_amdgcn_readfirstlane(tid >> 6), lane = tid & 63, wr = wid >> 2, wc = wid & 3, fr = lane & 15, fq = lane >> 4;
    const int K = g.K, nt = K / BK;
    unsigned voffA[2], voffB[2];
#pragma unroll
    for (int i = 0; i < 2; ++i) { int R, C; stage_rc(tid * 16 + i * 8192, R, C); const int Rb = Epi::PERM ? ((R & ~31) + perm32(R & 31)) : R;
        voffA[i] = (unsigned)(R * K + C) * 2u; voffB[i] = (unsigned)(Rb * K + C) * 2u; }
    const size_t kstep = (size_t)(BK * 2);
    const size_t hstep = (size_t)HALF * K * 2;
    const size_t tstep = 2 * hstep;
    const unsigned ldsw = (unsigned)wid * 1024u;
    const int aoff = lds_byte(wr * 64 + fr, fq * 8), boff = lds_byte(wc * 32 + fr, fq * 8);
#define PG8_SA(b, h) (((b) * 2 + (h)) * HTB)
#define PG8_SB(b, h) ((4 + (b) * 2 + (h)) * HTB)
#define PG8_STAGE(bufoff, gbase, voff) do { _Pragma("unroll") for (int _i = 0; _i < 2; ++_i) \
        __builtin_amdgcn_global_load_lds((const unsigned*)((const char*)(gbase) + (voff)[_i]), (PG8_LAS unsigned*)(lds + (bufoff) + ldsw + _i * 8192), 16, 0, 0); } while (0)
#define PG8_LDA(dst, b, h) do { _Pragma("unroll") for (int m = 0; m < 4; ++m) _Pragma("unroll") for (int k = 0; k < 2; ++k) dst[m][k] = *(const PG8_LAS bf16x8*)(lds + PG8_SA(b, h) + aoff + m * 2048 + k * 1024); } while (0)
#define PG8_LDB(dst, b, h) do { _Pragma("unroll") for (int n = 0; n < 2; ++n) _Pragma("unroll") for (int k = 0; k < 2; ++k) dst[n][k] = *(const PG8_LAS bf16x8*)(lds + PG8_SB(b, h) + boff + n * 2048 + k * 1024); } while (0)
#define PG8_MMA(ai, bj, At, Bt) do { __builtin_amdgcn_s_setprio(1); _Pragma("unroll") for (int m = 0; m < 4; ++m) _Pragma("unroll") for (int n = 0; n < 2; ++n) _Pragma("unroll") for (int k = 0; k < 2; ++k) \
        acc[ai][bj][m][n] = __builtin_amdgcn_mfma_f32_16x16x32_bf16(Bt[n][k], At[m][k], acc[ai][bj][m][n], 0, 0, 0); __builtin_amdgcn_s_setprio(0); } while (0)
#define PG8_WAIT_V(n) asm volatile("s_waitcnt vmcnt(" #n ")" ::: "memory")
#define PG8_WAIT_L(n) asm volatile("s_waitcnt lgkmcnt(" #n ")" ::: "memory")
#define PG8_BAR __builtin_amdgcn_s_barrier()
#define PG8_SCHED __builtin_amdgcn_sched_barrier(0)
    Unit cur, nxt; int ui = 0;
    if (!S.next(0, cur)) return;
    f32x4 acc[2][2][4][2];
#pragma unroll
    for (int a = 0; a < 2; ++a)
#pragma unroll
        for (int b = 0; b < 2; ++b)
#pragma unroll
            for (int m = 0; m < 4; ++m)
#pragma unroll
                for (int n = 0; n < 2; ++n) acc[a][b][m][n] = (f32x4){0.f, 0.f, 0.f, 0.f};
    bf16x8 At[4][2], B0[2][2], B1[2][2];
    const char* cA = (const char*)g.A + (size_t)cur.pm * tstep; const char* cB = (const char*)g.Bt + (size_t)cur.pn * tstep;
    S.a_ready(cur);
    if constexpr (SP2) {
        PG8_STAGE(PG8_SB(0, 0), cB, voffB); PG8_STAGE(PG8_SB(0, 1), cB + hstep, voffB); PG8_STAGE(PG8_SA(0, 0), cA, voffA); PG8_STAGE(PG8_SA(0, 1), cA + hstep, voffA);
        if (wr == 1) PG8_BAR;
        PG8_WAIT_V(2); PG8_BAR;
        PG8_STAGE(PG8_SB(1, 0), cB + kstep, voffB); PG8_STAGE(PG8_SA(1, 0), cA + kstep, voffA); PG8_STAGE(PG8_SB(1, 1), cB + hstep + kstep, voffB);
        PG8_WAIT_V(6); PG8_BAR;
    } else {
        PG8_STAGE(PG8_SB(0, 0), cB, voffB); PG8_STAGE(PG8_SA(0, 0), cA, voffA); PG8_STAGE(PG8_SB(0, 1), cB + hstep, voffB); PG8_STAGE(PG8_SA(0, 1), cA + hstep, voffA);
        if (wr == 1) PG8_BAR;
        PG8_WAIT_V(4); PG8_BAR;
        PG8_STAGE(PG8_SB(1, 0), cB + kstep, voffB); PG8_STAGE(PG8_SA(1, 0), cA + kstep, voffA); PG8_STAGE(PG8_SB(1, 1), cB + hstep + kstep, voffB);
        PG8_WAIT_V(6); PG8_BAR;
    }
    for (;;) {
        const bool has_next = S.next(ui + 1, nxt);
        const char* nA = has_next ? (const char*)g.A + (size_t)nxt.pm * tstep : cA; const char* nB = has_next ? (const char*)g.Bt + (size_t)nxt.pn * tstep : cB;
        for (int t = 0; t < nt; t += 2) {
            const bool last = (t == nt - 2);
            const char* a1 = cA + (size_t)(t + 1) * kstep;
            const char* a2 = last ? nA : cA + (size_t)(t + 2) * kstep; const char* b2 = last ? nB : cB + (size_t)(t + 2) * kstep;
            const char* a3 = a2 + kstep; const char* b3 = b2 + kstep;
            if (last && has_next) S.a_ready(nxt);
            if constexpr (SP2) {
            PG8_LDB(B0, 0, 0); PG8_LDB(B1, 0, 1); PG8_SCHED; PG8_LDA(At, 0, 0); PG8_STAGE(PG8_SA(1, 1), a1 + hstep, voffA);
            PG8_WAIT_V(8); PG8_WAIT_L(0); PG8_BAR; PG8_MMA(0, 0, At, B0); PG8_MMA(0, 1, At, B1); PG8_BAR; PG8_SCHED;
            PG8_LDA(At, 0, 1); PG8_STAGE(PG8_SB(0, 0), b2, voffB); PG8_STAGE(PG8_SB(0, 1), b2 + hstep, voffB); PG8_STAGE(PG8_SA(0, 0), a2, voffA);
            PG8_WAIT_V(8); PG8_WAIT_L(0); PG8_BAR; PG8_MMA(1, 0, At, B0); PG8_MMA(1, 1, At, B1); PG8_BAR; PG8_SCHED;
            PG8_LDB(B0, 1, 0); PG8_LDB(B1, 1, 1); PG8_SCHED; PG8_LDA(At, 1, 0); PG8_STAGE(PG8_SA(0, 1), a2 + hstep, voffA);
            PG8_WAIT_V(8); PG8_WAIT_L(0); PG8_BAR; PG8_MMA(0, 0, At, B0); PG8_MMA(0, 1, At, B1); PG8_BAR; PG8_SCHED;
            PG8_LDA(At, 1, 1); PG8_STAGE(PG8_SB(1, 0), b3, voffB); PG8_STAGE(PG8_SB(1, 1), b3 + hstep, voffB); PG8_STAGE(PG8_SA(1, 0), a3, voffA);
            PG8_WAIT_V(8); PG8_WAIT_L(0); PG8_BAR; PG8_MMA(1, 0, At, B0); PG8_MMA(1, 1, At, B1); PG8_BAR; PG8_SCHED;
            } else {
            PG8_LDB(B0, 0, 0); PG8_SCHED; PG8_LDA(At, 0, 0); PG8_STAGE(PG8_SA(1, 1), a1 + hstep, voffA);
            PG8_WAIT_L(8); PG8_BAR; PG8_WAIT_L(0); PG8_MMA(0, 0, At, B0); PG8_BAR; PG8_SCHED;
            PG8_LDB(B1, 0, 1); PG8_STAGE(PG8_SB(0, 0), b2, voffB);
            PG8_BAR; PG8_WAIT_L(0); PG8_MMA(0, 1, At, B1); PG8_BAR;
            PG8_LDA(At, 0, 1); PG8_STAGE(PG8_SA(0, 0), a2, voffA);
            PG8_BAR; PG8_WAIT_L(0); PG8_MMA(1, 0, At, B0); PG8_BAR; PG8_SCHED;
            PG8_STAGE(PG8_SB(0, 1), b2 + hstep, voffB);
            PG8_WAIT_V(6); PG8_BAR; PG8_MMA(1, 1, At, B1); PG8_BAR;
            PG8_LDB(B0, 1, 0); PG8_SCHED; PG8_LDA(At, 1, 0); PG8_STAGE(PG8_SA(0, 1), a2 + hstep, voffA);
            PG8_WAIT_L(8); PG8_BAR; PG8_WAIT_L(0); PG8_MMA(0, 0, At, B0); PG8_BAR; PG8_SCHED;
            PG8_LDB(B1, 1, 1); PG8_STAGE(PG8_SB(1, 0), b3, voffB);
            PG8_BAR; PG8_WAIT_L(0); PG8_MMA(0, 1, At, B1); PG8_BAR;
            PG8_LDA(At, 1, 1); PG8_STAGE(PG8_SA(1, 0), a3, voffA);
            PG8_BAR; PG8_WAIT_L(0); PG8_MMA(1, 0, At, B0); PG8_BAR; PG8_SCHED;
            PG8_STAGE(PG8_SB(1, 1), b3 + hstep, voffB);
            PG8_WAIT_V(6); PG8_BAR; PG8_MMA(1, 1, At, B1); PG8_BAR;
            }
        }
        if constexpr (ALIGN_EPI) { if (wr == 0) PG8_BAR; }
        if constexpr (!Epi::AFTER_DRAIN) { E(acc, cur, wr, wc, fr, fq); S.done(cur); }
        if (!has_next) break;
#pragma unroll
        for (int a = 0; a < 2; ++a)
#pragma unroll
            for (int b = 0; b < 2; ++b)
#pragma unroll
                for (int m = 0; m < 4; ++m)
#pragma unroll
                    for (int n = 0; n < 2; ++n) acc[a][b][m][n] = (f32x4){0.f, 0.f, 0.f, 0.f};
        cur = nxt; cA = nA; cB = nB; ++ui;
        if constexpr (ALIGN_EPI) { if (wr == 1) PG8_BAR; }
    }
    PG8_WAIT_V(0);
    if constexpr (!ALIGN_EPI) { if (wr == 0) PG8_BAR; }
    PG8_BAR;
    if constexpr (Epi::AFTER_DRAIN) { E.fused(acc, cur, wr, wc, fr, fq, lds, wid, lane); S.done(cur); }
#undef PG8_SA
#undef PG8_SB
#undef PG8_STAGE
#undef PG8_LDA
#undef PG8_LDB
#undef PG8_MMA
#undef PG8_WAIT_V
#undef PG8_WAIT_L
#undef PG8_BAR
#undef PG8_SCHED
}
}

constexpr size_t MiB = 1u << 20;
constexpr size_t WS_CTL = 0, CTL_ZERO_BYTES = 1 * MiB;
constexpr size_t WS_ROPE = 1 * MiB;
constexpr size_t WS_LB = 2 * MiB;
constexpr size_t WS_WATTIN = 4 * MiB;
constexpr size_t WS_WATTOUT = 76 * MiB;
constexpr size_t WS_WRECIN = 84 * MiB;
constexpr size_t WS_WRECOUT = 148 * MiB;
constexpr size_t WS_WFF1 = 164 * MiB;
constexpr size_t WS_WFF2 = 292 * MiB;
constexpr size_t WS_XN = 420 * MiB;
constexpr size_t WS_BIG = 452 * MiB;
constexpr size_t WS_Y = 612 * MiB;
constexpr size_t WS_AUX = 676 * MiB;
constexpr size_t WS_OB = 836 * MiB;
constexpr size_t WS_END = 868 * MiB;
constexpr size_t AUX_OG = 0, AUX_LSE = 96 * MiB;
constexpr size_t AUX_HO = 0;

constexpr int NWAVES = 8;
constexpr int RING_BYTES = 131072;
constexpr int LDSCTL_OFF = RING_BYTES, MISC_OFF = LDSCTL_OFF + 320;
constexpr int LDS_BYTES = 147456;
constexpr int CW_TMO = 0, CW_CODE = 1, CW_BAR = 4096;

#define GAS __attribute__((address_space(1)))
#define LAS __attribute__((address_space(3)))
typedef unsigned short bf16;
typedef unsigned v4u __attribute__((ext_vector_type(4)));
typedef float f32x4 __attribute__((ext_vector_type(4)));
typedef short bf16x8 __attribute__((ext_vector_type(8)));
typedef GAS unsigned gu32;
typedef GAS unsigned long long gu64;
#define RLX_AGENT __ATOMIC_RELAXED, __HIP_MEMORY_SCOPE_AGENT
#define LDS_WAIT() asm volatile("s_waitcnt lgkmcnt(0)" ::: "memory")
#define VM_WAIT() asm volatile("s_waitcnt vmcnt(0)" ::: "memory")
__device__ __forceinline__ unsigned long long rt() { return __builtin_amdgcn_s_memrealtime(); }
__device__ __forceinline__ unsigned f2bf(float f) { unsigned u = __builtin_bit_cast(unsigned, f); return (u + 0x7fffu + ((u >> 16) & 1u)) >> 16; }
__device__ __forceinline__ unsigned pk2(float lo, float hi) { return f2bf(lo) | (f2bf(hi) << 16); }

#define XB_TMO      128
#define XB_XCNT(j)  (256  + 64 * (j))
#define XB_XSUB(j)  (1280 + 64 * (j))
#define XB_XGEN(j)  (2304 + 64 * (j))
#define XB_TOP      3328
#define XB_TOPGEN   3392
#define XCD_BAR_WORDS 3456
#define XB_SPIN_CAP (1u << 18)

__device__ __forceinline__ unsigned xb_ld(unsigned* p)              { return __hip_atomic_load(p, __ATOMIC_RELAXED, __HIP_MEMORY_SCOPE_AGENT); }
__device__ __forceinline__ unsigned xb_add(unsigned* p, unsigned v) { return __hip_atomic_fetch_add(p, v, __ATOMIC_RELAXED, __HIP_MEMORY_SCOPE_AGENT); }
__device__ __forceinline__ unsigned xb_xcc_id() { return (unsigned)__builtin_amdgcn_s_getreg((3 << 11) | 20) & 0xFu; }
#define XB_SPIN(cond, bar) do { unsigned _sp = 0; while (cond) { __builtin_amdgcn_s_sleep(1); \
    if ((++_sp & 255u) == 0u) { if (xb_ld(&(bar)[XB_TMO])) break; if (_sp > XB_SPIN_CAP) { atomicAdd(&(bar)[XB_TMO], 1u); break; } } } } while (0)

struct XcdBarrier {
    unsigned* bar; unsigned x;
    volatile LAS unsigned* st;
};

__device__ __forceinline__ XcdBarrier xcd_barrier_post(unsigned* bar, volatile LAS unsigned* st) {
    XcdBarrier b; b.bar = bar; b.x = xb_xcc_id(); b.st = st;
    if (threadIdx.x == 0) (void)xb_add(&bar[XB_XCNT(b.x)], 1u);
    return b;
}
__device__ __forceinline__ void xcd_barrier_complete(unsigned* bar, unsigned x, unsigned& nloc, unsigned& nx) {
    const unsigned G = gridDim.x * gridDim.y * gridDim.z;
    unsigned sum, cnt, mine, sp = 0u;
    for (;;) {
        sum = 0u; cnt = 0u; mine = 0u;
#pragma unroll
        for (unsigned j = 0; j < 16; ++j) { const unsigned c = xb_ld(&bar[XB_XCNT(j)]); sum += c; cnt += (c > 0u) ? 1u : 0u; mine = (j == x) ? c : mine; }
        if (sum == G) break;
        __builtin_amdgcn_s_sleep(1);
        if ((++sp & 255u) == 0u) { if (xb_ld(&bar[XB_TMO])) break; if (sp > XB_SPIN_CAP) { atomicAdd(&bar[XB_TMO], 1u); break; } }
    }
    nloc = mine > 0u ? mine : 1u; nx = cnt > 0u ? cnt : 1u;
}

__device__ __forceinline__ void xcd_barrier(const XcdBarrier& b) {
    asm volatile("s_waitcnt vmcnt(0)" ::: "memory");
    __syncthreads();
    if (threadIdx.x == 0) {
        unsigned* bar = b.bar;
        __builtin_amdgcn_s_waitcnt(0);
        unsigned nloc = b.st[0], nx = b.st[1];
        if (nloc == 0u) { xcd_barrier_complete(bar, b.x, nloc, nx); b.st[0] = nloc; b.st[1] = nx; }
        const unsigned old = xb_add(&bar[XB_XSUB(b.x)], 1u);
        const unsigned gen = old / nloc;
        if (old + 1u == (gen + 1u) * nloc) {
            __builtin_amdgcn_fence(__ATOMIC_RELEASE, "agent");
            asm volatile("s_waitcnt vmcnt(0)" ::: "memory");
            const unsigned og = xb_add(&bar[XB_TOP], 1u);
            const unsigned tg = og / nx;
            if (og + 1u == (tg + 1u) * nx) xb_add(&bar[XB_TOPGEN], 1u);
            else XB_SPIN(xb_ld(&bar[XB_TOPGEN]) == tg, bar);
            __builtin_amdgcn_fence(__ATOMIC_ACQUIRE, "agent");
            xb_add(&bar[XB_XGEN(b.x)], 1u);
            asm volatile("s_waitcnt vmcnt(0)" ::: "memory");
        } else {
            XB_SPIN(xb_ld(&bar[XB_XGEN(b.x)]) == gen, bar);
            __builtin_amdgcn_fence(__ATOMIC_ACQUIRE, "agent");
            asm volatile("s_waitcnt vmcnt(0)" ::: "memory");
        }
    }
    __syncthreads();
}


struct Frame {
    LAS unsigned char* lds;
    volatile LAS unsigned* MISC;
    gu32* ctl;
    int tid, lane, wave;
    int vcu, G;
};
__device__ __forceinline__ float wave_sum(float v) {
#pragma unroll
    for (int o = 1; o < 64; o <<= 1) v += __shfl_xor(v, o);
    return v;
}
__device__ __forceinline__ float wave_max(float v) {
#pragma unroll
    for (int o = 1; o < 64; o <<= 1) v = fmaxf(v, __shfl_xor(v, o));
    return v;
}
__device__ __forceinline__ float bf2f(unsigned short b) { return __builtin_bit_cast(float, ((unsigned)b) << 16); }
__device__ __forceinline__ float bflo(unsigned w) { return __builtin_bit_cast(float, w << 16); }
__device__ __forceinline__ float bfhi(unsigned w) { return __builtin_bit_cast(float, w & 0xffff0000u); }

__host__ __device__ __forceinline__ int rec_phys_row(int n) { const int type = n >> 11, h = (n & 2047) >> 7, c = n & 127; return 512 * h + 128 * type + c; }

template <bool RECPERM>
__device__ __forceinline__ void p0_transpose_item(const float* __restrict__ W, int K, int N, bf16* __restrict__ WT, LAS unsigned* scr, int item, int lane) {
    const int nblk = N / 64, kb = item / nblk, nb = item % nblk, k0 = 64 * kb, n0 = 64 * nb;
    const int c4 = lane & 15, kr = lane >> 4;
#pragma unroll
    for (int i = 0; i < 8; ++i) {
        const int k = k0 + 8 * i + 2 * kr;
        const f32x4 a = *(const f32x4*)(W + (size_t)k * N + n0 + 4 * c4);
        const f32x4 b = *(const f32x4*)(W + (size_t)(k + 1) * N + n0 + 4 * c4);
#pragma unroll
        for (int j = 0; j < 4; ++j) scr[(4 * c4 + j) * 33 + 4 * i + kr] = pk2(a[j], b[j]);
    }
    LDS_WAIT(); asm volatile("" ::: "memory");
    const int np0 = RECPERM ? rec_phys_row(n0) : n0;
#pragma unroll
    for (int i2 = 0; i2 < 8; ++i2) {
        const int n = 8 * i2 + (lane >> 3), kc = lane & 7;
        v4u o; o.x = scr[n * 33 + 4 * kc + 0]; o.y = scr[n * 33 + 4 * kc + 1]; o.z = scr[n * 33 + 4 * kc + 2]; o.w = scr[n * 33 + 4 * kc + 3];
        *(v4u*)(WT + (size_t)(np0 + n) * K + k0 + 8 * kc) = o;
    }
    LDS_WAIT(); asm volatile("" ::: "memory");
}
template <bool RECPERM>
__device__ __forceinline__ void p0_transpose(Frame& F, const float* W, int K, int N, bf16* WT, int nmat) {
    LAS unsigned* scr = (LAS unsigned*)(F.lds + F.wave * 16384);
    const int gw = F.vcu * NWAVES + F.wave, NGW = F.G * NWAVES;
    const int per = (K / 64) * (N / 64), total = per * nmat;
    for (int it = gw; it < total; it += NGW) {
        const int mi = it / per, r = it % per;
        p0_transpose_item<RECPERM>(W + (size_t)mi * K * N, K, N, WT + (size_t)mi * K * N, scr, r, F.lane);
    }
}

__device__ const double kInvFreq[16] = {1.0, 0.44036660267178046, 0.19392274474868576, 0.08539710028576561, 0.03760603093086393, 0.016560440080994446, 0.007292664737217109, 0.003211445994752591,
    0.001414213562373095, 0.000622772421914596, 0.0002742481756762073, 0.00012076973741146504, 5.318295896944988e-05, 2.341999896140934e-05, 1.031338537721246e-05, 4.5416704806078695e-06};
__device__ __forceinline__ void p0_tables(Frame& F, const int* positions, const float* rlb, float* cs, float* sn, float* lbt) {
    const int gt = F.vcu * NWAVES * 64 + F.tid, NT = F.G * NWAVES * 64;
    for (int i = gt; i < M * 16; i += NT) {
        const int m = i >> 4, f = i & 15;
        const double invf = kInvFreq[f];
        double ang = (double)positions[m] * invf;
        ang -= 6.283185307179586476925 * (double)__builtin_rint(ang * 0.15915494309189533577);
        const float ar = (float)ang;
        cs[i] = cosf(ar); sn[i] = sinf(ar);
    }
    for (int c = gt; c < 2048; c += NT) {
        const float r0 = rlb[c], r1 = rlb[2048 + c];
        const float mx = fmaxf(r0, r1), e0 = expf(r0 - mx), e1 = expf(r1 - mx);
        const float lb1 = e1 / (e0 + e1);
        lbt[0 * 4096 + c] = 1e-30f;            lbt[0 * 4096 + 2048 + c] = 1.0f;
        lbt[1 * 4096 + c] = fmaxf(lb1, 1e-30f); lbt[1 * 4096 + 2048 + c] = 1.0f - lb1;
    }
}

__device__ __forceinline__ void phase_thin(Frame& F, const float* Y, const float* hin, float* hout, const float* gpost, const float* gpre, bf16* XN) {
    const int gw = F.vcu * NWAVES + F.wave, NGW = F.G * NWAVES;
    for (int m = gw; m < M; m += NGW) {
        const f32x4* hr = (const f32x4*)(hin + (size_t)m * D) + F.lane;
        f32x4 hv[8];
#pragma unroll
        for (int j = 0; j < 8; ++j) hv[j] = hr[64 * j];
        if (Y) {
            const f32x4* yr = (const f32x4*)(Y + (size_t)m * D) + F.lane;
            f32x4 yv[8]; float ss = 0.f;
#pragma unroll
            for (int j = 0; j < 8; ++j) { yv[j] = yr[64 * j]; ss += (yv[j].x * yv[j].x + yv[j].y * yv[j].y) + (yv[j].z * yv[j].z + yv[j].w * yv[j].w); }
            const float r1 = 1.0f / sqrtf(wave_sum(ss) * (1.0f / D) + NORM_EPS);
#pragma unroll
            for (int j = 0; j < 8; ++j) { const f32x4 g = ((const f32x4*)gpost)[F.lane + 64 * j]; hv[j] = hv[j] + yv[j] * r1 * g; }
        }
        f32x4* ho = (f32x4*)(hout + (size_t)m * D) + F.lane;
#pragma unroll
        for (int j = 0; j < 8; ++j) ho[64 * j] = hv[j];
        if (XN) {
            float s2 = 0.f;
#pragma unroll
            for (int j = 0; j < 8; ++j) s2 += (hv[j].x * hv[j].x + hv[j].y * hv[j].y) + (hv[j].z * hv[j].z + hv[j].w * hv[j].w);
            const float r2 = 1.0f / sqrtf(wave_sum(s2) * (1.0f / D) + NORM_EPS);
            unsigned long long* o8 = (unsigned long long*)(XN + (size_t)m * D) + F.lane;
#pragma unroll
            for (int j = 0; j < 8; ++j) { const f32x4 g = ((const f32x4*)gpre)[F.lane + 64 * j]; const f32x4 o = hv[j] * r2 * g;
                o8[64 * j] = (unsigned long long)pk2(o.x, o.y) | ((unsigned long long)pk2(o.z, o.w) << 32); }
        }
    }
}

__device__ __forceinline__ float dot128_bf16(const bf16* a, const bf16* b) {
    float s = 0.f;
#pragma unroll
    for (int i = 0; i < 16; ++i) { const v4u x = *(const v4u*)(a + 8 * i), y = *(const v4u*)(b + 8 * i);
        s += bflo(x.x) * bflo(y.x) + bfhi(x.x) * bfhi(y.x) + bflo(x.y) * bflo(y.y) + bfhi(x.y) * bfhi(y.y)
           + bflo(x.z) * bflo(y.z) + bfhi(x.z) * bfhi(y.z) + bflo(x.w) * bflo(y.w) + bfhi(x.w) * bfhi(y.w); }
    return s;
}
__device__ __forceinline__ void phase_attn_naive(Frame& F, const bf16* QKV, float* og, float* lse) {
    const int gw = F.vcu * NWAVES + F.wave, NGW = F.G * NWAVES, lane = F.lane;
    for (int task = gw; task < M * 24; task += NGW) {
        const int m = task / 24, gh = task % 24, g = gh >> 3, h = gh & 7;
        const int b = m / SEQ, t = m % SEQ;
        const int dil = (g == 0) ? 1 : (g == 1 ? 4 : 16);
        const int p = t / dil;
        const bf16* qp = QKV + (size_t)m * ATT_IN + g * 3072 + h * HD;
        float sc[3]; bool ok[3];
#pragma unroll
        for (int kk = 0; kk < 3; ++kk) {
            const int dist = lane + 64 * kk; ok[kk] = (dist <= 128) && (dist <= p);
            sc[kk] = -3.0e38f;
            if (ok[kk]) { const int t2 = t - dist * dil; sc[kk] = dot128_bf16(qp, QKV + (size_t)(b * SEQ + t2) * ATT_IN + g * 3072 + 1024 + h * HD); }
        }
        const float mx = wave_max(fmaxf(fmaxf(sc[0], sc[1]), sc[2]));
        float pe[3]; float ls = 0.f;
#pragma unroll
        for (int kk = 0; kk < 3; ++kk) { pe[kk] = ok[kk] ? exp2f(sc[kk] - mx) : 0.f; ls += pe[kk]; }
        const float l = wave_sum(ls);
        float o0 = 0.f, o1 = 0.f;
        for (int kk = 0; kk < 3; ++kk) {
            const int nmax = (kk == 2) ? 1 : 64;
            for (int sl = 0; sl < nmax; ++sl) {
                const float pk = __shfl(pe[kk], sl);
                const int dist = sl + 64 * kk;
                if (dist <= p && dist <= 128) {
                    const int t2 = t - dist * dil;
                    const unsigned w = *(const unsigned*)(QKV + (size_t)(b * SEQ + t2) * ATT_IN + g * 3072 + 2048 + h * HD + 2 * lane);
                    o0 += pk * bflo(w); o1 += pk * bfhi(w);
                }
            }
        }
        const float inv = 1.0f / l;
        float* op = og + ((size_t)g * M + m) * ATT_OUT + h * HD + 2 * lane;
        op[0] = o0 * inv; op[1] = o1 * inv;
        if (lane == 0) lse[((size_t)g * M + m) * 8 + h] = mx + log2f(l);
    }
}
__device__ __forceinline__ void phase_combine(Frame& F, const float* og, const float* lse, bf16* OB) {
    const int gw = F.vcu * NWAVES + F.wave, NGW = F.G * NWAVES, lane = F.lane;
    for (int m = gw; m < M; m += NGW) {
        const int h = lane >> 3;
        const float l0 = lse[((size_t)0 * M + m) * 8 + h], l1 = lse[((size_t)1 * M + m) * 8 + h], l2 = lse[((size_t)2 * M + m) * 8 + h];
        const float mx = fmaxf(fmaxf(l0, l1), l2);
        float w0 = exp2f(l0 - mx), w1 = exp2f(l1 - mx), w2 = exp2f(l2 - mx);
        const float inv = 1.0f / (w0 + w1 + w2); w0 *= inv; w1 *= inv; w2 *= inv;
        const f32x4* a0 = (const f32x4*)(og + ((size_t)0 * M + m) * ATT_OUT + 16 * lane);
        const f32x4* a1 = (const f32x4*)(og + ((size_t)1 * M + m) * ATT_OUT + 16 * lane);
        const f32x4* a2 = (const f32x4*)(og + ((size_t)2 * M + m) * ATT_OUT + 16 * lane);
        unsigned wds[8];
#pragma unroll
        for (int j = 0; j < 4; ++j) { const f32x4 o = a0[j] * w0 + a1[j] * w1 + a2[j] * w2; wds[2 * j] = pk2(o.x, o.y); wds[2 * j + 1] = pk2(o.z, o.w); }
        v4u* dst = (v4u*)(OB + (size_t)m * ATT_OUT + 16 * lane);
        dst[0] = (v4u){wds[0], wds[1], wds[2], wds[3]}; dst[1] = (v4u){wds[4], wds[5], wds[6], wds[7]};
    }
}

__device__ __forceinline__ void phase_hgrn_naive(Frame& F, const bf16* P, const float* lbt  , float* ho) {
    LAS float* sq = (LAS float*)(F.lds);
    LAS float* sf = sq + 128;
    LAS float* sk = sf + 128;
    LAS float* sv = sk + 128;
    LAS float* part = sv + 128;
    const int tid = F.tid, n = tid & 127, kq = tid >> 7;
    for (int unit = F.vcu; unit < BATCH * 16; unit += F.G) {
        const int b = unit >> 4, h = unit & 15;
        float S[32];
#pragma unroll
        for (int i = 0; i < 32; ++i) S[i] = 0.f;
        for (int t = 0; t < SEQ; ++t) {
            const bf16* row = P + (size_t)(b * SEQ + t) * REC_IN + 512 * h;
            if (tid < 128) {
                const float q = bf2f(row[tid]), z = bf2f(row[128 + tid]), v = bf2f(row[256 + tid]);
                const float lbc = lbt[h * 128 + tid], oml = lbt[2048 + h * 128 + tid];
                const float s = 1.0f / (1.0f + expf(-z));
                sq[tid] = q; sf[tid] = lbc + oml * s; sk[tid] = oml * (1.0f - s); sv[tid] = v;
            }
            __syncthreads();
            const float v = sv[n]; float acc = 0.f;
#pragma unroll
            for (int i = 0; i < 32; ++i) { const int k = kq * 32 + i; S[i] = sf[k] * S[i] + sk[k] * v; acc += sq[k] * S[i]; }
            part[kq * 128 + n] = acc;
            __syncthreads();
            if (tid < 128) ho[(size_t)(b * SEQ + t) * D + h * 128 + tid] = (part[tid] + part[128 + tid]) + (part[256 + tid] + part[384 + tid]);
        }
        __syncthreads();
    }
}
__device__ __forceinline__ void phase_normgate(Frame& F, const float* ho, const bf16* P, const float* gnorm, bf16* OB) {
    const int gw = F.vcu * NWAVES + F.wave, NGW = F.G * NWAVES, lane = F.lane;
    const f32x4 gn = *(const f32x4*)(gnorm + 4 * (lane & 31));
    for (int m = gw; m < M; m += NGW) {
        const f32x4* orow = (const f32x4*)(ho + (size_t)m * D) + lane;
        unsigned long long* o8 = (unsigned long long*)(OB + (size_t)m * D) + lane;
#pragma unroll
        for (int j = 0; j < 8; ++j) {
            const f32x4 v = orow[64 * j];
            float ss = (v.x * v.x + v.y * v.y) + (v.z * v.z + v.w * v.w);
#pragma unroll
            for (int o = 1; o < 32; o <<= 1) ss += __shfl_xor(ss, o);
            const float r = 1.0f / sqrtf(ss * (1.0f / 128.0f) + NORM_EPS);
            const int h = 2 * j + (lane >> 5);
            const unsigned long long gw8 = *(const unsigned long long*)(P + (size_t)m * REC_IN + 512 * h + 384 + 4 * (lane & 31));
            const unsigned glo = (unsigned)gw8, ghi = (unsigned)(gw8 >> 32);
            const float g0 = bflo(glo), g1 = bfhi(glo), g2 = bflo(ghi), g3 = bfhi(ghi);
            const float s0 = g0 / (1.0f + expf(-g0)), s1 = g1 / (1.0f + expf(-g1)), s2 = g2 / (1.0f + expf(-g2)), s3 = g3 / (1.0f + expf(-g3));
            o8[64 * j] = (unsigned long long)pk2(v.x * r * gn.x * s0, v.y * r * gn.y * s1) | ((unsigned long long)pk2(v.z * r * gn.z * s2, v.w * r * gn.w * s3) << 32);
        }
    }
}


typedef short s16x4 __attribute__((ext_vector_type(4)));
__device__ __forceinline__ unsigned att_off(unsigned row, unsigned ch) { return 256u * row + 16u * (ch ^ (((row & 3) << 2) | ((row >> 2) & 3))); }
struct AttUnit { int g, dil, b, res, blk, h; };
__device__ __forceinline__ void att_decode(int u, AttUnit& a) {
    a.g = u >> 9; const int r = u & 511; a.h = r & 7; const int nbk = r >> 3;
    a.dil = (a.g == 0) ? 1 : (a.g == 1 ? 4 : 16);
    const int nb = 16 / a.dil;
    const int n = nbk / nb; a.blk = nbk % nb; a.b = n / a.dil; a.res = n % a.dil;
}
__device__ __forceinline__ int att_row(const AttUnit& a, int j) { const int p = 128 * (a.blk - 1) + j; return a.b * SEQ + a.res + a.dil * p; }
__device__ __forceinline__ void att_load(const AttUnit& a, const bf16* QKV, int tid, v4u (&kr)[8], v4u (&vr)[8]) {
#pragma unroll
    for (int i = 0; i < 8; ++i) {
        const int idx = tid + 512 * i, row = idx >> 4, ch = idx & 15;
        if (a.blk > 0 || row >= 128) {
            const bf16* p = QKV + (size_t)att_row(a, row) * ATT_IN + a.g * 3072 + a.h * HD + ch * 8;
            kr[i] = *(const v4u*)(p + 1024); vr[i] = *(const v4u*)(p + 2048);
        } else { kr[i] = (v4u){0u, 0u, 0u, 0u}; vr[i] = (v4u){0u, 0u, 0u, 0u}; }
    }
}
__device__ __forceinline__ void phase_attn(Frame& F, const bf16* QKV, float* og, float* lse) {
    LAS unsigned char* Ks = F.lds; LAS unsigned char* Vs = F.lds + 65536;
    const int tid = F.tid, lane = F.lane, w = F.wave, li = lane & 15, g4 = lane >> 4;
    const int nunits = 1536;
    int u = blockIdx.x;
    if (u >= nunits) return;
    AttUnit a; att_decode(u, a);
    v4u kr[8], vr[8];
    att_load(a, QKV, tid, kr, vr);
    const int wb = (w < 6) ? w : 6;
    for (;;) {
#pragma unroll
        for (int i = 0; i < 8; ++i) { const int idx = tid + 512 * i, row = idx >> 4, ch = idx & 15; const unsigned o = att_off(row, ch);
            *(LAS v4u*)(Ks + o) = kr[i]; *(LAS v4u*)(Vs + o) = vr[i]; }
        const int qi = 16 * w + li;
        const int mq = att_row(a, 128 + qi);
        bf16x8 qf[4];
        { const bf16* qp = QKV + (size_t)mq * ATT_IN + a.g * 3072 + a.h * HD + 8 * g4;
#pragma unroll
          for (int ks = 0; ks < 4; ++ks) qf[ks] = *(const bf16x8*)(qp + 32 * ks); }
        __syncthreads();
        const AttUnit cur = a;
        const int un = u + gridDim.x; const bool has_next = un < nunits;
        if (has_next) { att_decode(un, a); att_load(a, QKV, tid, kr, vr); }
        f32x4 s[10];
#pragma unroll
        for (int tt = 0; tt < 10; ++tt) {
            s[tt] = (f32x4){0.f, 0.f, 0.f, 0.f};
            const unsigned krow = 16 * (wb + tt) + li;
#pragma unroll
            for (int ks = 0; ks < 4; ++ks) { const bf16x8 kf = *(const LAS bf16x8*)(Ks + att_off(krow, 4 * ks + g4));
                s[tt] = __builtin_amdgcn_mfma_f32_16x16x32_bf16(kf, qf[ks], s[tt], 0, 0, 0); }
        }
        float mx = -1.0e30f;
#pragma unroll
        for (int tt = 0; tt < 10; ++tt)
#pragma unroll
            for (int r = 0; r < 4; ++r) { const int j = 16 * (wb + tt) + 4 * g4 + r;
                const bool ok = (j >= qi) && (j <= qi + 128) && (cur.blk > 0 || j >= 128);
                s[tt][r] = ok ? s[tt][r] : -1.0e30f; mx = fmaxf(mx, s[tt][r]); }
        mx = fmaxf(mx, __shfl_xor(mx, 16)); mx = fmaxf(mx, __shfl_xor(mx, 32));
        float ls = 0.f;
#pragma unroll
        for (int tt = 0; tt < 10; ++tt)
#pragma unroll
            for (int r = 0; r < 4; ++r) { const float p = (s[tt][r] > -1.0e29f) ? exp2f(s[tt][r] - mx) : 0.f; s[tt][r] = p; ls += p; }
        ls += __shfl_xor(ls, 16); ls += __shfl_xor(ls, 32);
        bf16x8 pf[5];
#pragma unroll
        for (int ps = 0; ps < 5; ++ps) { const unsigned w0 = pk2(s[2 * ps][0], s[2 * ps][1]), w1 = pk2(s[2 * ps][2], s[2 * ps][3]), w2 = pk2(s[2 * ps + 1][0], s[2 * ps + 1][1]), w3 = pk2(s[2 * ps + 1][2], s[2 * ps + 1][3]);
            const v4u t4 = {w0, w1, w2, w3}; pf[ps] = __builtin_bit_cast(bf16x8, t4); }
        const float inv = 1.0f / ls;
        const int q4 = li >> 2, p4 = li & 3;
        float* orow = og + ((size_t)cur.g * M + mq) * ATT_OUT + cur.h * HD + 4 * g4;
#pragma unroll
        for (int c = 0; c < 8; ++c) {
            f32x4 o = {0.f, 0.f, 0.f, 0.f};
#pragma unroll
            for (int ps = 0; ps < 5; ++ps) {
                const unsigned r0 = 16 * (wb + 2 * ps) + 4 * g4 + q4, r1 = r0 + 16;
                const s16x4 va = __builtin_amdgcn_ds_read_tr16_b64_v4i16((LAS s16x4*)(Vs + att_off(r0, 2 * c + (p4 >> 1)) + 8 * (p4 & 1)));
                const s16x4 vb = __builtin_amdgcn_ds_read_tr16_b64_v4i16((LAS s16x4*)(Vs + att_off(r1, 2 * c + (p4 >> 1)) + 8 * (p4 & 1)));
                const bf16x8 vf = {va[0], va[1], va[2], va[3], vb[0], vb[1], vb[2], vb[3]};
                o = __builtin_amdgcn_mfma_f32_16x16x32_bf16(vf, pf[ps], o, 0, 0, 0);
            }
            *(f32x4*)(orow + 16 * c) = o * inv;
        }
        if (g4 == 0) lse[((size_t)cur.g * M + mq) * 8 + cur.h] = mx + log2f(ls);
        if (!has_next) break;
        u = un;
        __syncthreads();
    }
}

struct Args { const float* in[11]; float* out; unsigned char* ws; };

__device__ __forceinline__ void frame_refresh(Frame& F) {
    int t = threadIdx.x; asm volatile("" : "+v"(t)); F.tid = t; F.lane = t & 63; F.wave = __builtin_amdgcn_readfirstlane(t >> 6);
}
__device__ __forceinline__ void frame_init(Frame& F, unsigned char* lds, unsigned char* ws) {
    F.lds = (LAS unsigned char*)lds;
    F.MISC = (volatile LAS unsigned*)(F.lds + MISC_OFF);
    F.tid = threadIdx.x; F.lane = F.tid & 63; F.wave = __builtin_amdgcn_readfirstlane(F.tid >> 6);
    F.G = gridDim.x; { const int bx = blockIdx.x; F.vcu = (F.G % 8 == 0) ? (bx % 8) * (F.G / 8) + bx / 8 : bx; }
    F.ctl = (gu32*)(ws + WS_CTL);
}


__device__ __noinline__ void grid_bar_call(unsigned* barw, unsigned x, volatile LAS unsigned* st) { XcdBarrier b; b.bar = barw; b.x = x; b.st = st; xcd_barrier(b); }
__global__ void __launch_bounds__(NWAVES * 64, 2) mega_fwd(Args args) {
    extern __shared__ __attribute__((aligned(16))) unsigned char lds[];
    Frame F; frame_init(F, lds, args.ws);
    unsigned char* ws = args.ws;
    const float* x = args.in[0]; const int* positions = (const int*)args.in[1]; const float* gains = args.in[2];
    const float* w_att_in = args.in[3]; const float* w_att_out = args.in[4]; const float* w_rec_in = args.in[5];
    const float* rlb = args.in[6]; const float* rec_norm = args.in[7]; const float* w_rec_out = args.in[8];
    const float* w_ff1 = args.in[9]; const float* w_ff2 = args.in[10];
    float* hbuf = args.out;
    bf16* XN = (bf16*)(ws + WS_XN); bf16* BIG = (bf16*)(ws + WS_BIG); float* Y = (float*)(ws + WS_Y); bf16* OB = (bf16*)(ws + WS_OB);
    float* cs = (float*)(ws + WS_ROPE); float* sn = cs + M * 16; float* lbt = (float*)(ws + WS_LB);
    for (int u = F.tid; u < (LDS_BYTES - LDSCTL_OFF) / 4; u += NWAVES * 64) ((LAS unsigned*)(F.lds + LDSCTL_OFF))[u] = 0u;
    __syncthreads();
    XcdBarrier bar = xcd_barrier_post((unsigned*)(F.ctl + CW_BAR), F.MISC + 8);
#define GRID_BAR() grid_bar_call(bar.bar, bar.x, bar.st)

    p0_transpose<false>(F, w_att_in, D, ATT_IN, (bf16*)(ws + WS_WATTIN), 2);
    p0_transpose<false>(F, w_att_out, ATT_OUT, D, (bf16*)(ws + WS_WATTOUT), 2);
    p0_transpose<true>(F, w_rec_in, D, REC_IN, (bf16*)(ws + WS_WRECIN), 2);
    p0_transpose<false>(F, w_rec_out, D, D, (bf16*)(ws + WS_WRECOUT), 2);
    p0_transpose<false>(F, w_ff1, D, DFF, (bf16*)(ws + WS_WFF1), 4);
    p0_transpose<false>(F, w_ff2, DFF, D, (bf16*)(ws + WS_WFF2), 4);
    p0_tables(F, positions, rlb, cs, sn, lbt);
    phase_thin(F, nullptr, x, hbuf, nullptr, gains, XN);
    GRID_BAR();

    for (int layer = 0; layer < DEPTH; ++layer) {
        const int j = layer >> 1;
        const float* g = gains + (size_t)layer * 4 * D;
        if ((layer & 1) == 0) {
            {   pg8::Gemm gm{XN, (const bf16*)(ws + WS_WATTIN) + (size_t)j * ATT_IN * D, M, ATT_IN, D}; pg8::StaticOrder S; S.init(M, ATT_IN, F.G, (int)blockIdx.x);
                pg8::EpiQKV E{BIG, ATT_IN, cs, sn, QSCALE};
                pg8::gemm_phase<pg8::EpiQKV, pg8::StaticOrder, true, true>(F.lds, gm, S, E); }
            GRID_BAR();
            frame_refresh(F); phase_attn(F, BIG, (float*)(ws + WS_AUX + AUX_OG), (float*)(ws + WS_AUX + AUX_LSE));
            GRID_BAR();
            frame_refresh(F); phase_combine(F, (const float*)(ws + WS_AUX + AUX_OG), (const float*)(ws + WS_AUX + AUX_LSE), OB);
            GRID_BAR();
            {   pg8::Gemm gm{OB, (const bf16*)(ws + WS_WATTOUT) + (size_t)j * D * ATT_OUT, M, D, ATT_OUT}; pg8::StaticOrder S; S.init(M, D, F.G, (int)blockIdx.x);
                pg8::EpiF32 E{Y, D};
                pg8::gemm_phase<pg8::EpiF32, pg8::StaticOrder, true, true>(F.lds, gm, S, E); }
            GRID_BAR();
        } else {
            {   pg8::Gemm gm{XN, (const bf16*)(ws + WS_WRECIN) + (size_t)j * REC_IN * D, M, REC_IN, D}; pg8::StaticOrder S; S.init(M, REC_IN, F.G, (int)blockIdx.x);
                pg8::EpiBf16<0> E{BIG, REC_IN};
                pg8::gemm_phase<pg8::EpiBf16<0>, pg8::StaticOrder, true, true>(F.lds, gm, S, E); }
            GRID_BAR();
            frame_refresh(F); phase_hgrn_naive(F, BIG, lbt + (size_t)j * 4096, (float*)(ws + WS_AUX + AUX_HO));
            GRID_BAR();
            frame_refresh(F); phase_normgate(F, (const float*)(ws + WS_AUX + AUX_HO), BIG, rec_norm + (size_t)j * HD, OB);
            GRID_BAR();
            {   pg8::Gemm gm{OB, (const bf16*)(ws + WS_WRECOUT) + (size_t)j * D * D, M, D, D}; pg8::StaticOrder S; S.init(M, D, F.G, (int)blockIdx.x);
                pg8::EpiF32 E{Y, D};
                pg8::gemm_phase<pg8::EpiF32, pg8::StaticOrder, true, true>(F.lds, gm, S, E); }
            GRID_BAR();
        }
        frame_refresh(F); phase_thin(F, Y, hbuf, hbuf, g + D, g + 2 * D, XN);
        GRID_BAR();
        {   pg8::Gemm gm{XN, (const bf16*)(ws + WS_WFF1) + (size_t)layer * DFF * D, M, DFF, D}; pg8::StaticOrder S; S.init(M, DFF, F.G, (int)blockIdx.x);
            pg8::EpiBf16<1> E{BIG, DFF};
            pg8::gemm_phase<pg8::EpiBf16<1>, pg8::StaticOrder, true, true>(F.lds, gm, S, E); }
        GRID_BAR();
        {   pg8::Gemm gm{BIG, (const bf16*)(ws + WS_WFF2) + (size_t)layer * D * DFF, M, D, DFF}; pg8::StaticOrder S; S.init(M, D, F.G, (int)blockIdx.x);
            pg8::EpiF32 E{Y, D};
            pg8::gemm_phase<pg8::EpiF32, pg8::StaticOrder, true, true>(F.lds, gm, S, E); }
        GRID_BAR();
        {   const bool last = (layer == DEPTH - 1);
            frame_refresh(F); phase_thin(F, Y, hbuf, hbuf, g + 3 * D, last ? nullptr : (g + 4 * D), last ? nullptr : XN); }
        if (layer != DEPTH - 1) GRID_BAR();
    }
    if (xb_ld(bar.bar + XB_TMO) != 0u) {
        const int gw = F.vcu * NWAVES + F.wave, NGW = F.G * NWAVES; const float q = __builtin_nanf("");
        for (int m = gw; m < M; m += NGW) { f32x4* o = (f32x4*)(hbuf + (size_t)m * D) + F.lane;
#pragma unroll
            for (int jj = 0; jj < 8; ++jj) o[64 * jj] = (f32x4){q, q, q, q}; }
    }
#undef GRID_BAR
}

extern "C" void kernel_launch(void* const* d_in, const int* in_sizes, int n_in, void* d_out, int out_size, void* d_ws, size_t ws_size, hipStream_t stream) {
    static int grid = 0;
    if (grid == 0) {
        if (n_in != 11 || out_size != M * D || ws_size < WS_END) { fprintf(stderr, "kernel_launch: unexpected shapes (n_in %d, out %d, ws %zu)\n", n_in, out_size, ws_size); grid = -1; return; }
        int dev = 0, cus = 0, per_cu = 0;
        if (hipGetDevice(&dev) != hipSuccess || hipDeviceGetAttribute(&cus, hipDeviceAttributeMultiprocessorCount, dev) != hipSuccess) { grid = -1; return; }
        if (hipFuncSetAttribute((const void*)mega_fwd, hipFuncAttributeMaxDynamicSharedMemorySize, LDS_BYTES) != hipSuccess) { grid = -1; return; }
        if (hipOccupancyMaxActiveBlocksPerMultiprocessor(&per_cu, (const void*)mega_fwd, NWAVES * 64, LDS_BYTES) != hipSuccess || per_cu < 1)
            fprintf(stderr, "kernel_launch: note: occupancy query reports %d workgroups per CU\n", per_cu);
        (void)hipGetLastError();
        grid = cus;
    }
    if (grid < 0) return;
    (void)hipMemsetAsync((char*)d_ws + WS_CTL, 0, CTL_ZERO_BYTES, stream);
    Args a{};
    for (int i = 0; i < 11; ++i) a.in[i] = (const float*)d_in[i];
    a.out = (float*)d_out; a.ws = (unsigned char*)d_ws;
    hipLaunchKernelGGL(mega_fwd, dim3(grid), dim3(NWAVES * 64), LDS_BYTES, stream, a);
}
```

```cpp
#include <hip/hip_runtime.h>
#include <cstdio>
#include <cstdint>

constexpr int BATCH = 4, SEQ = 2048, D = 2048, DEPTH = 4;
constexpr int M = BATCH * SEQ;
constexpr int ATT_IN = 9216, ATT_OUT = 1024, REC_IN = 8192, DFF = 8192;
constexpr int HD = 128;
constexpr float NORM_EPS = 1e-6f;
constexpr float QSCALE = 0.08838834764831845f * 1.4426950408889634f;

namespace pg8 {
#define PG8_LAS __attribute__((address_space(3)))
typedef unsigned short bf16_t;
typedef short bf16x8 __attribute__((ext_vector_type(8)));
typedef float f32x4 __attribute__((ext_vector_type(4)));
typedef unsigned u32x4 __attribute__((ext_vector_type(4)));
constexpr int BM = 256, BK = 64, HALF = 128, HTB = HALF * BK * 2  , STAGE_BYTES = 8 * HTB, NXCD = 8, WGM = 8;

__host__ __device__ __forceinline__ int lds_byte(int r, int c) { const int st = (r >> 4) * 2 + (c >> 5), rr = r & 15, cc = c & 31, ob = rr * 64 + cc * 2; return st * 1024 + (ob ^ (((ob >> 9) & 1) << 5)); }
__host__ __device__ __forceinline__ void stage_rc(int b, int& R, int& C) { const int st = b / 1024, sb = b % 1024, swz = sb ^ (((sb >> 9) & 1) << 5); R = (st >> 1) * 16 + swz / 64; C = (st & 1) * 32 + (swz % 64) / 2; }
__host__ __device__ __forceinline__ int perm32(int rho) { const int n = rho >> 4, i = rho & 15; return 8 * (i >> 2) + 4 * n + (i & 3); }

struct Unit { int pm, pn; };
struct Gemm { const bf16_t* A; const bf16_t* Bt; int M, N, K; };

struct StaticOrder {
    int nM, nN, nwg, G, c;
    __host__ __device__ void init(int M, int N, int G_, int c_) { nM = M / BM; nN = N / BM; nwg = nM * nN; G = G_; c = c_; }
    __host__ __device__ bool next(int i, Unit& u) const {
        const long L = (long)i * G + c; if (L >= nwg) return false;
        int wgid = (int)L; { const int q = nwg / NXCD, r = nwg % NXCD, xcd = wgid % NXCD, off = wgid / NXCD; wgid = (xcd < r ? xcd * (q + 1) : r * (q + 1) + (xcd - r) * q) + off; }
        const int nig = WGM * nN, gid = wgid / nig, fm = gid * WGM, gsz = (nM - fm) < WGM ? (nM - fm) : WGM;
        u.pm = fm + ((wgid % nig) % gsz); u.pn = (wgid % nig) / gsz; return true;
    }
    __device__ __forceinline__ void a_ready(const Unit&) const {}
    __device__ __forceinline__ void done(const Unit&) const {}
};

__device__ __forceinline__ unsigned cvt_pk_bf16(float lo, float hi) { unsigned r; asm volatile("v_cvt_pk_bf16_f32 %0, %1, %2" : "=v"(r) : "v"(lo), "v"(hi)); return r; }

struct EpiF32 {
    static constexpr bool PERM = false, AFTER_DRAIN = false;
    float* C; int ldc;
    __device__ __forceinline__ void operator()(const f32x4 (&acc)[2][2][4][2], const Unit& u, int wr, int wc, int fr, int fq) const {
        const int row0 = u.pm * BM + wr * 64 + fr, col0 = u.pn * BM + wc * 32 + 4 * fq;
#pragma unroll
        for (int ai = 0; ai < 2; ++ai)
#pragma unroll
            for (int m = 0; m < 4; ++m) { float* rowp = C + (size_t)(row0 + ai * HALF + m * 16) * ldc + col0;
#pragma unroll
                for (int bj = 0; bj < 2; ++bj)
#pragma unroll
                    for (int n = 0; n < 2; ++n) *(f32x4*)(rowp + bj * HALF + n * 16) = acc[ai][bj][m][n]; }
    }
};
template <int ACT  > struct EpiBf16 {
    static constexpr bool PERM = true, AFTER_DRAIN = false;
    bf16_t* O; int ldc;
    __device__ __forceinline__ void operator()(const f32x4 (&acc)[2][2][4][2], const Unit& u, int wr, int wc, int fr, int fq) const {
        const int row0 = u.pm * BM + wr * 64 + fr, col0 = u.pn * BM + wc * 32 + 8 * fq;
#pragma unroll
        for (int ai = 0; ai < 2; ++ai)
#pragma unroll
            for (int m = 0; m < 4; ++m) { bf16_t* rowp = O + (size_t)(row0 + ai * HALF + m * 16) * ldc + col0;
#pragma unroll
                for (int bj = 0; bj < 2; ++bj) { f32x4 v0 = acc[ai][bj][m][0], v1 = acc[ai][bj][m][1];
                    if (ACT == 1) {
#pragma unroll
                        for (int j = 0; j < 4; ++j) { const float a = fmaxf(v0[j], 0.f), b = fmaxf(v1[j], 0.f); v0[j] = a * a; v1[j] = b * b; } }
                    u32x4 w; w.x = cvt_pk_bf16(v0[0], v0[1]); w.y = cvt_pk_bf16(v0[2], v0[3]); w.z = cvt_pk_bf16(v1[0], v1[1]); w.w = cvt_pk_bf16(v1[2], v1[3]);
                    *(u32x4*)(rowp + bj * HALF) = w; } }
    }
};
struct EpiQKV {
    static constexpr bool PERM = true, AFTER_DRAIN = false;
    bf16_t* O; int ldc; const float* cs; const float* sn; float qscale;
    __device__ __forceinline__ void operator()(const f32x4 (&acc)[2][2][4][2], const Unit& u, int wr, int wc, int fr, int fq) const {
        const int row0 = u.pm * BM + wr * 64 + fr, col0 = u.pn * BM + wc * 32 + 8 * fq;
        const int t = (u.pn % 12) >> 2;
        const bool rope = (t < 2) && (wc == 0);
        const float sc = (t == 0) ? qscale : 1.0f;
        const bool upper = fq >= 2;
#pragma unroll
        for (int ai = 0; ai < 2; ++ai)
#pragma unroll
            for (int m = 0; m < 4; ++m) { const int row = row0 + ai * HALF + m * 16; bf16_t* rowp = O + (size_t)row * ldc + col0;
                f32x4 c0 = {1.f, 1.f, 1.f, 1.f}, c1 = c0, s0 = {0.f, 0.f, 0.f, 0.f}, s1 = s0;
                if (rope) { const float* cp = cs + (size_t)row * 16 + 8 * (fq & 1); const float* sp = sn + (size_t)row * 16 + 8 * (fq & 1);
                    c0 = *(const f32x4*)cp; c1 = *(const f32x4*)(cp + 4); s0 = *(const f32x4*)sp; s1 = *(const f32x4*)(sp + 4); }
#pragma unroll
                for (int bj = 0; bj < 2; ++bj) { f32x4 v0 = acc[ai][bj][m][0], v1 = acc[ai][bj][m][1];
                    if (rope) {
#pragma unroll
                        for (int j = 0; j < 4; ++j) {
                            const float p0 = __shfl_xor(v0[j], 32), p1 = __shfl_xor(v1[j], 32);
                            v0[j] = upper ? (v0[j] * c0[j] + p0 * s0[j]) : (v0[j] * c0[j] - p0 * s0[j]);
                            v1[j] = upper ? (v1[j] * c1[j] + p1 * s1[j]) : (v1[j] * c1[j] - p1 * s1[j]); } }
                    v0 = v0 * sc; v1 = v1 * sc;
                    u32x4 w; w.x = cvt_pk_bf16(v0[0], v0[1]); w.y = cvt_pk_bf16(v0[2], v0[3]); w.z = cvt_pk_bf16(v1[0], v1[1]); w.w = cvt_pk_bf16(v1[2], v1[3]);
                    *(u32x4*)(rowp + bj * HALF) = w; } }
    }
};

struct EpiRec {
    static constexpr bool PERM = true, AFTER_DRAIN = false;
    bf16_t *QT, *KT, *KH, *VV, *GT; float* DL; const float* lbt;
    __device__ __forceinline__ void operator()(const f32x4 (&acc)[2][2][4][2], const Unit& u, int wr, int wc, int fr, int fq) const {
        const int h = u.pn >> 1, row0 = u.pm * BM + wr * 64 + fr, c8 = h * 128 + wc * 32 + 8 * fq;
        if (u.pn & 1) {
#pragma unroll
            for (int ai = 0; ai < 2; ++ai)
#pragma unroll
                for (int m = 0; m < 4; ++m) { const size_t off = (size_t)(row0 + ai * HALF + m * 16) * 2048 + c8;
#pragma unroll
                    for (int bj = 0; bj < 2; ++bj) { const f32x4 v0 = acc[ai][bj][m][0], v1 = acc[ai][bj][m][1];
                        u32x4 w; w.x = cvt_pk_bf16(v0[0], v0[1]); w.y = cvt_pk_bf16(v0[2], v0[3]); w.z = cvt_pk_bf16(v1[0], v1[1]); w.w = cvt_pk_bf16(v1[2], v1[3]);
                        *(u32x4*)((bj ? GT : VV) + off) = w; } }
            return;
        }
        float lbc[8], oml[8];
#pragma unroll
        for (int i = 0; i < 8; ++i) { lbc[i] = lbt[c8 + i]; oml[i] = lbt[2048 + c8 + i]; }
#pragma unroll
        for (int ai = 0; ai < 2; ++ai)
#pragma unroll
            for (int m = 0; m < 4; ++m) {
                const int row = row0 + ai * HALF + m * 16; const size_t off = (size_t)row * 2048 + c8;
                float qt[8], kt[8], kh[8], dl[8];
#pragma unroll
                for (int i = 0; i < 8; ++i) {
                    const float qv = acc[ai][0][m][i >> 2][i & 3], z = acc[ai][1][m][i >> 2][i & 3];
                    const float e = expf(fminf(-z, 80.0f)), s = 1.0f / (1.0f + e);
                    const float lf = logf(lbc[i] + oml[i] * s), kk = oml[i] * (e * s);
                    float b = lf;
#pragma unroll
                    for (int d = 1; d < 16; d <<= 1) { const float t = __shfl_up(b, d, 16); if (fr >= d) b += t; }
                    const float bl = __shfl(b, 15, 16);
                    qt[i] = qv * expf(b); kt[i] = kk * expf(fminf(-b, 80.0f)); kh[i] = kk * expf(bl - b); dl[i] = expf(bl);
                }
                u32x4 w;
                w.x = cvt_pk_bf16(qt[0], qt[1]); w.y = cvt_pk_bf16(qt[2], qt[3]); w.z = cvt_pk_bf16(qt[4], qt[5]); w.w = cvt_pk_bf16(qt[6], qt[7]); *(u32x4*)(QT + off) = w;
                w.x = cvt_pk_bf16(kt[0], kt[1]); w.y = cvt_pk_bf16(kt[2], kt[3]); w.z = cvt_pk_bf16(kt[4], kt[5]); w.w = cvt_pk_bf16(kt[6], kt[7]); *(u32x4*)(KT + off) = w;
                w.x = cvt_pk_bf16(kh[0], kh[1]); w.y = cvt_pk_bf16(kh[2], kh[3]); w.z = cvt_pk_bf16(kh[4], kh[5]); w.w = cvt_pk_bf16(kh[6], kh[7]); *(u32x4*)(KH + off) = w;
                if (fr == 0) { float* dp = DL + (size_t)(row >> 4) * 2048 + c8; *(f32x4*)dp = (f32x4){dl[0], dl[1], dl[2], dl[3]}; *(f32x4*)(dp + 4) = (f32x4){dl[4], dl[5], dl[6], dl[7]}; }
            }
    }
};

template <class Epi, class Sched, bool ALIGN_EPI = false, bool SP2 = false>
__device__ __forceinline__ void gemm_phase(PG8_LAS unsigned char* lds, const Gemm g, const Sched& S, const Epi& E) {
    int tid_ = threadIdx.x; asm volatile("" : "+v"(tid_));
    const int tid = tid_, wid = __builtin_amdgcn_readfirstlane(tid >> 6), lane = tid & 63, wr = wid >> 2, wc = wid & 3, fr = lane & 15, fq = lane >> 4;
    const int K = g.K, nt = K / BK;
    unsigned voffA[2], voffB[2];
#pragma unroll
    for (int i = 0; i < 2; ++i) { int R, C; stage_rc(tid * 16 + i * 8192, R, C); const int Rb = Epi::PERM ? ((R & ~31) + perm32(R & 31)) : R;
        voffA[i] = (unsigned)(R * K + C) * 2u; voffB[i] = (unsigned)(Rb * K + C) * 2u; }
    const size_t kstep = (size_t)(BK * 2);
    const size_t hstep = (size_t)HALF * K * 2;
    const size_t tstep = 2 * hstep;
    const unsigned ldsw = (unsigned)wid * 1024u;
    const int aoff = lds_byte(wr * 64 + fr, fq * 8), boff = lds_byte(wc * 32 + fr, fq * 8);
#define PG8_SA(b, h) (((b) * 2 + (h)) * HTB)
#define PG8_SB(b, h) ((4 + (b) * 2 + (h)) * HTB)
#define PG8_STAGE(bufoff, gbase, voff) do { _Pragma("unroll") for (int _i = 0; _i < 2; ++_i) \
        __builtin_amdgcn_global_load_lds((const unsigned*)((const char*)(gbase) + (voff)[_i]), (PG8_LAS unsigned*)(lds + (bufoff) + ldsw + _i * 8192), 16, 0, 0); } while (0)
#define PG8_LDA(dst, b, h) do { _Pragma("unroll") for (int m = 0; m < 4; ++m) _Pragma("unroll") for (int k = 0; k < 2; ++k) dst[m][k] = *(const PG8_LAS bf16x8*)(lds + PG8_SA(b, h) + aoff + m * 2048 + k * 1024); } while (0)
#define PG8_LDB(dst, b, h) do { _Pragma("unroll") for (int n = 0; n < 2; ++n) _Pragma("unroll") for (int k = 0; k < 2; ++k) dst[n][k] = *(const PG8_LAS bf16x8*)(lds + PG8_SB(b, h) + boff + n * 2048 + k * 1024); } while (0)
#define PG8_MMA(ai, bj, At, Bt) do { __builtin_amdgcn_s_setprio(1); _Pragma("unroll") for (int m = 0; m < 4; ++m) _Pragma("unroll") for (int n = 0; n < 2; ++n) _Pragma("unroll") for (int k = 0; k < 2; ++k) \
        acc[ai][bj][m][n] = __builtin_amdgcn_mfma_f32_16x16x32_bf16(Bt[n][k], At[m][k], acc[ai][bj][m][n], 0, 0, 0); __builtin_amdgcn_s_setprio(0); } while (0)
#define PG8_WAIT_V(n) asm volatile("s_waitcnt vmcnt(" #n ")" ::: "memory")
#define PG8_WAIT_L(n) asm volatile("s_waitcnt lgkmcnt(" #n ")" ::: "memory")
#define PG8_BAR __builtin_amdgcn_s_barrier()
#define PG8_SCHED __builtin_amdgcn_sched_barrier(0)
    Unit cur, nxt; int ui = 0;
    if (!S.next(0, cur)) return;
    f32x4 acc[2][2][4][2];
#pragma unroll
    for (int a = 0; a < 2; ++a)
#pragma unroll
        for (int b = 0; b < 2; ++b)
#pragma unroll
            for (int m = 0; m < 4; ++m)
#pragma unroll
                for (int n = 0; n < 2; ++n) acc[a][b][m][n] = (f32x4){0.f, 0.f, 0.f, 0.f};
    bf16x8 At[4][2], B0[2][2], B1[2][2];
    const char* cA = (const char*)g.A + (size_t)cur.pm * tstep; const char* cB = (const char*)g.Bt + (size_t)cur.pn * tstep;
    S.a_ready(cur);
    if constexpr (SP2) {
        PG8_STAGE(PG8_SB(0, 0), cB, voffB); PG8_STAGE(PG8_SB(0, 1), cB + hstep, voffB); PG8_STAGE(PG8_SA(0, 0), cA, voffA); PG8_STAGE(PG8_SA(0, 1), cA + hstep, voffA);
        if (wr == 1) PG8_BAR;
        PG8_WAIT_V(2); PG8_BAR;
        PG8_STAGE(PG8_SB(1, 0), cB + kstep, voffB); PG8_STAGE(PG8_SA(1, 0), cA + kstep, voffA); PG8_STAGE(PG8_SB(1, 1), cB + hstep + kstep, voffB);
        PG8_WAIT_V(6); PG8_BAR;
    } else {
        PG8_STAGE(PG8_SB(0, 0), cB, voffB); PG8_STAGE(PG8_SA(0, 0), cA, voffA); PG8_STAGE(PG8_SB(0, 1), cB + hstep, voffB); PG8_STAGE(PG8_SA(0, 1), cA + hstep, voffA);
        if (wr == 1) PG8_BAR;
        PG8_WAIT_V(4); PG8_BAR;
        PG8_STAGE(PG8_SB(1, 0), cB + kstep, voffB); PG8_STAGE(PG8_SA(1, 0), cA + kstep, voffA); PG8_STAGE(PG8_SB(1, 1), cB + hstep + kstep, voffB);
        PG8_WAIT_V(6); PG8_BAR;
    }
    for (;;) {
        const bool has_next = S.next(ui + 1, nxt);
        const char* nA = has_next ? (const char*)g.A + (size_t)nxt.pm * tstep : cA; const char* nB = has_next ? (const char*)g.Bt + (size_t)nxt.pn * tstep : cB;
        for (int t = 0; t < nt; t += 2) {
            const bool last = (t == nt - 2);
            const char* a1 = cA + (size_t)(t + 1) * kstep;
            const char* a2 = last ? nA : cA + (size_t)(t + 2) * kstep; const char* b2 = last ? nB : cB + (size_t)(t + 2) * kstep;
            const char* a3 = a2 + kstep; const char* b3 = b2 + kstep;
            if (last && has_next) S.a_ready(nxt);
            if constexpr (SP2) {
            PG8_LDB(B0, 0, 0); PG8_LDB(B1, 0, 1); PG8_SCHED; PG8_LDA(At, 0, 0); PG8_STAGE(PG8_SA(1, 1), a1 + hstep, voffA);
            PG8_WAIT_V(8); PG8_WAIT_L(0); PG8_BAR; PG8_MMA(0, 0, At, B0); PG8_MMA(0, 1, At, B1); PG8_BAR; PG8_SCHED;
            PG8_LDA(At, 0, 1); PG8_STAGE(PG8_SB(0, 0), b2, voffB); PG8_STAGE(PG8_SB(0, 1), b2 + hstep, voffB); PG8_STAGE(PG8_SA(0, 0), a2, voffA);
            PG8_WAIT_V(8); PG8_WAIT_L(0); PG8_BAR; PG8_MMA(1, 0, At, B0); PG8_MMA(1, 1, At, B1); PG8_BAR; PG8_SCHED;
            PG8_LDB(B0, 1, 0); PG8_LDB(B1, 1, 1); PG8_SCHED; PG8_LDA(At, 1, 0); PG8_STAGE(PG8_SA(0, 1), a2 + hstep, voffA);
            PG8_WAIT_V(8); PG8_WAIT_L(0); PG8_BAR; PG8_MMA(0, 0, At, B0); PG8_MMA(0, 1, At, B1); PG8_BAR; PG8_SCHED;
            PG8_LDA(At, 1, 1); PG8_STAGE(PG8_SB(1, 0), b3, voffB); PG8_STAGE(PG8_SB(1, 1), b3 + hstep, voffB); PG8_STAGE(PG8_SA(1, 0), a3, voffA);
            PG8_WAIT_V(8); PG8_WAIT_L(0); PG8_BAR; PG8_MMA(1, 0, At, B0); PG8_MMA(1, 1, At, B1); PG8_BAR; PG8_SCHED;
            } else {
            PG8_LDB(B0, 0, 0); PG8_SCHED; PG8_LDA(At, 0, 0); PG8_STAGE(PG8_SA(1, 1), a1 + hstep, voffA);
            PG8_WAIT_L(8); PG8_BAR; PG8_WAIT_L(0); PG8_MMA(0, 0, At, B0); PG8_BAR; PG8_SCHED;
            PG8_LDB(B1, 0, 1); PG8_STAGE(PG8_SB(0, 0), b2, voffB);
            PG8_BAR; PG8_WAIT_L(0); PG8_MMA(0, 1, At, B1); PG8_BAR;
            PG8_LDA(At, 0, 1); PG8_STAGE(PG8_SA(0, 0), a2, voffA);
            PG8_BAR; PG8_WAIT_L(0); PG8_MMA(1, 0, At, B0); PG8_BAR; PG8_SCHED;
            PG8_STAGE(PG8_SB(0, 1), b2 + hstep, voffB);
            PG8_WAIT_V(6); PG8_BAR; PG8_MMA(1, 1, At, B1); PG8_BAR;
            PG8_LDB(B0, 1, 0); PG8_SCHED; PG8_LDA(At, 1, 0); PG8_STAGE(PG8_SA(0, 1), a2 + hstep, voffA);
            PG8_WAIT_L(8); PG8_BAR; PG8_WAIT_L(0); PG8_MMA(0, 0, At, B0); PG8_BAR; PG8_SCHED;
            PG8_LDB(B1, 1, 1); PG8_STAGE(PG8_SB(1, 0), b3, voffB);
            PG8_BAR; PG8_WAIT_L(0); PG8_MMA(0, 1, At, B1); PG8_BAR;
            PG8_LDA(At, 1, 1); PG8_STAGE(PG8_SA(1, 0), a3, voffA);
            PG8_BAR; PG8_WAIT_L(0); PG8_MMA(1, 0, At, B0); PG8_BAR; PG8_SCHED;
            PG8_STAGE(PG8_SB(1, 1), b3 + hstep, voffB);
            PG8_WAIT_V(6); PG8_BAR; PG8_MMA(1, 1, At, B1); PG8_BAR;
            }
        }
        if constexpr (ALIGN_EPI) { if (wr == 0) PG8_BAR; }
        if constexpr (!Epi::AFTER_DRAIN) { E(acc, cur, wr, wc, fr, fq); S.done(cur); }
        if (!has_next) break;
#pragma unroll
        for (int a = 0; a < 2; ++a)
#pragma unroll
            for (int b = 0; b < 2; ++b)
#pragma unroll
                for (int m = 0; m < 4; ++m)
#pragma unroll
                    for (int n = 0; n < 2; ++n) acc[a][b][m][n] = (f32x4){0.f, 0.f, 0.f, 0.f};
        cur = nxt; cA = nA; cB = nB; ++ui;
        if constexpr (ALIGN_EPI) { if (wr == 1) PG8_BAR; }
    }
    PG8_WAIT_V(0);
    if constexpr (!ALIGN_EPI) { if (wr == 0) PG8_BAR; }
    PG8_BAR;
    if constexpr (Epi::AFTER_DRAIN) { E.fused(acc, cur, wr, wc, fr, fq, lds, wid, lane); S.done(cur); }
#undef PG8_SA
#undef PG8_SB
#undef PG8_STAGE
#undef PG8_LDA
#undef PG8_LDB
#undef PG8_MMA
#undef PG8_WAIT_V
#undef PG8_WAIT_L
#undef PG8_BAR
#undef PG8_SCHED
}
}

constexpr size_t MiB = 1u << 20;
constexpr size_t WS_CTL = 0, CTL_ZERO_BYTES = 1 * MiB;
constexpr size_t WS_ROPE = 1 * MiB;
constexpr size_t WS_LB = 2 * MiB;
constexpr size_t WS_WATTIN = 4 * MiB;
constexpr size_t WS_WATTOUT = 76 * MiB;
constexpr size_t WS_WRECIN = 84 * MiB;
constexpr size_t WS_WRECOUT = 148 * MiB;
constexpr size_t WS_WFF1 = 164 * MiB;
constexpr size_t WS_WFF2 = 292 * MiB;
constexpr size_t WS_XN = 420 * MiB;
constexpr size_t WS_BIG = 452 * MiB;
constexpr size_t WS_Y = 612 * MiB;
constexpr size_t WS_AUX = 676 * MiB;
constexpr size_t WS_OB = 836 * MiB;
constexpr size_t WS_END = 868 * MiB;
constexpr size_t AUX_OG = 0, AUX_LSE = 96 * MiB;
constexpr size_t AUX_HO = 0, AUX_DL = 64 * MiB, AUX_E = 68 * MiB, AUX_DSEG = 100 * MiB;

constexpr int NWAVES = 8;
constexpr int RING_BYTES = 131072;
constexpr int LDSCTL_OFF = RING_BYTES, MISC_OFF = LDSCTL_OFF + 320;
constexpr int LDS_BYTES = 147456;
constexpr int CW_TMO = 0, CW_CODE = 1, CW_BAR = 4096;

#define GAS __attribute__((address_space(1)))
#define LAS __attribute__((address_space(3)))
typedef unsigned short bf16;
typedef unsigned v4u __attribute__((ext_vector_type(4)));
typedef float f32x4 __attribute__((ext_vector_type(4)));
typedef short bf16x8 __attribute__((ext_vector_type(8)));
typedef GAS unsigned gu32;
typedef GAS unsigned long long gu64;
#define RLX_AGENT __ATOMIC_RELAXED, __HIP_MEMORY_SCOPE_AGENT
#define LDS_WAIT() asm volatile("s_waitcnt lgkmcnt(0)" ::: "memory")
#define VM_WAIT() asm volatile("s_waitcnt vmcnt(0)" ::: "memory")
__device__ __forceinline__ unsigned long long rt() { return __builtin_amdgcn_s_memrealtime(); }
__device__ __forceinline__ unsigned f2bf(float f) { unsigned u = __builtin_bit_cast(unsigned, f); return (u + 0x7fffu + ((u >> 16) & 1u)) >> 16; }
__device__ __forceinline__ unsigned pk2(float lo, float hi) { return f2bf(lo) | (f2bf(hi) << 16); }

#define XB_TMO      128
#define XB_XCNT(j)  (256  + 64 * (j))
#define XB_XSUB(j)  (1280 + 64 * (j))
#define XB_XGEN(j)  (2304 + 64 * (j))
#define XB_TOP      3328
#define XB_TOPGEN   3392
#define XCD_BAR_WORDS 3456
#define XB_SPIN_CAP (1u << 18)

__device__ __forceinline__ unsigned xb_ld(unsigned* p)              { return __hip_atomic_load(p, __ATOMIC_RELAXED, __HIP_MEMORY_SCOPE_AGENT); }
__device__ __forceinline__ unsigned xb_add(unsigned* p, unsigned v) { return __hip_atomic_fetch_add(p, v, __ATOMIC_RELAXED, __HIP_MEMORY_SCOPE_AGENT); }
__device__ __forceinline__ unsigned xb_xcc_id() { return (unsigned)__builtin_amdgcn_s_getreg((3 << 11) | 20) & 0xFu; }
#define XB_SPIN(cond, bar) do { unsigned _sp = 0; while (cond) { __builtin_amdgcn_s_sleep(1); \
    if ((++_sp & 255u) == 0u) { if (xb_ld(&(bar)[XB_TMO])) break; if (_sp > XB_SPIN_CAP) { atomicAdd(&(bar)[XB_TMO], 1u); break; } } } } while (0)

struct XcdBarrier {
    unsigned* bar; unsigned x;
    volatile LAS unsigned* st;
};

__device__ __forceinline__ XcdBarrier xcd_barrier_post(unsigned* bar, volatile LAS unsigned* st) {
    XcdBarrier b; b.bar = bar; b.x = xb_xcc_id(); b.st = st;
    if (threadIdx.x == 0) (void)xb_add(&bar[XB_XCNT(b.x)], 1u);
    return b;
}
__device__ __forceinline__ void xcd_barrier_complete(unsigned* bar, unsigned x, unsigned& nloc, unsigned& nx) {
    const unsigned G = gridDim.x * gridDim.y * gridDim.z;
    unsigned sum, cnt, mine, sp = 0u;
    for (;;) {
        sum = 0u; cnt = 0u; mine = 0u;
#pragma unroll
        for (unsigned j = 0; j < 16; ++j) { const unsigned c = xb_ld(&bar[XB_XCNT(j)]); sum += c; cnt += (c > 0u) ? 1u : 0u; mine = (j == x) ? c : mine; }
        if (sum == G) break;
        __builtin_amdgcn_s_sleep(1);
        if ((++sp & 255u) == 0u) { if (xb_ld(&bar[XB_TMO])) break; if (sp > XB_SPIN_CAP) { atomicAdd(&bar[XB_TMO], 1u); break; } }
    }
    nloc = mine > 0u ? mine : 1u; nx = cnt > 0u ? cnt : 1u;
}

__device__ __forceinline__ void xcd_barrier(const XcdBarrier& b) {
    asm volatile("s_waitcnt vmcnt(0)" ::: "memory");
    __syncthreads();
    if (threadIdx.x == 0) {
        unsigned* bar = b.bar;
        __builtin_amdgcn_s_waitcnt(0);
        unsigned nloc = b.st[0], nx = b.st[1];
        if (nloc == 0u) { xcd_barrier_complete(bar, b.x, nloc, nx); b.st[0] = nloc; b.st[1] = nx; }
        const unsigned old = xb_add(&bar[XB_XSUB(b.x)], 1u);
        const unsigned gen = old / nloc;
        if (old + 1u == (gen + 1u) * nloc) {
            __builtin_amdgcn_fence(__ATOMIC_RELEASE, "agent");
            asm volatile("s_waitcnt vmcnt(0)" ::: "memory");
            const unsigned og = xb_add(&bar[XB_TOP], 1u);
            const unsigned tg = og / nx;
            if (og + 1u == (tg + 1u) * nx) xb_add(&bar[XB_TOPGEN], 1u);
            else XB_SPIN(xb_ld(&bar[XB_TOPGEN]) == tg, bar);
            __builtin_amdgcn_fence(__ATOMIC_ACQUIRE, "agent");
            xb_add(&bar[XB_XGEN(b.x)], 1u);
            asm volatile("s_waitcnt vmcnt(0)" ::: "memory");
        } else {
            XB_SPIN(xb_ld(&bar[XB_XGEN(b.x)]) == gen, bar);
            __builtin_amdgcn_fence(__ATOMIC_ACQUIRE, "agent");
            asm volatile("s_waitcnt vmcnt(0)" ::: "memory");
        }
    }
    __syncthreads();
}


struct Frame {
    LAS unsigned char* lds;
    volatile LAS unsigned* MISC;
    gu32* ctl;
    int tid, lane, wave;
    int vcu, G;
};
__device__ __forceinline__ float wave_sum(float v) {
#pragma unroll
    for (int o = 1; o < 64; o <<= 1) v += __shfl_xor(v, o);
    return v;
}
__device__ __forceinline__ float wave_max(float v) {
#pragma unroll
    for (int o = 1; o < 64; o <<= 1) v = fmaxf(v, __shfl_xor(v, o));
    return v;
}
__device__ __forceinline__ float bf2f(unsigned short b) { return __builtin_bit_cast(float, ((unsigned)b) << 16); }
__device__ __forceinline__ float bflo(unsigned w) { return __builtin_bit_cast(float, w << 16); }
__device__ __forceinline__ float bfhi(unsigned w) { return __builtin_bit_cast(float, w & 0xffff0000u); }

__host__ __device__ __forceinline__ int rec_phys_row(int n) { const int type = n >> 11, h = (n & 2047) >> 7, c = n & 127; return 512 * h + 128 * type + c; }

template <bool RECPERM>
__device__ __forceinline__ void p0_transpose_item(const float* __restrict__ W, int K, int N, bf16* __restrict__ WT, LAS unsigned* scr, int item, int lane) {
    const int nblk = N / 64, kb = item / nblk, nb = item % nblk, k0 = 64 * kb, n0 = 64 * nb;
    const int c4 = lane & 15, kr = lane >> 4;
#pragma unroll
    for (int i = 0; i < 8; ++i) {
        const int k = k0 + 8 * i + 2 * kr;
        const f32x4 a = *(const f32x4*)(W + (size_t)k * N + n0 + 4 * c4);
        const f32x4 b = *(const f32x4*)(W + (size_t)(k + 1) * N + n0 + 4 * c4);
#pragma unroll
        for (int j = 0; j < 4; ++j) scr[(4 * c4 + j) * 33 + 4 * i + kr] = pk2(a[j], b[j]);
    }
    LDS_WAIT(); asm volatile("" ::: "memory");
    const int np0 = RECPERM ? rec_phys_row(n0) : n0;
#pragma unroll
    for (int i2 = 0; i2 < 8; ++i2) {
        const int n = 8 * i2 + (lane >> 3), kc = lane & 7;
        v4u o; o.x = scr[n * 33 + 4 * kc + 0]; o.y = scr[n * 33 + 4 * kc + 1]; o.z = scr[n * 33 + 4 * kc + 2]; o.w = scr[n * 33 + 4 * kc + 3];
        *(v4u*)(WT + (size_t)(np0 + n) * K + k0 + 8 * kc) = o;
    }
    LDS_WAIT(); asm volatile("" ::: "memory");
}
template <bool RECPERM>
__device__ __forceinline__ void p0_transpose(Frame& F, const float* W, int K, int N, bf16* WT, int nmat) {
    LAS unsigned* scr = (LAS unsigned*)(F.lds + F.wave * 16384);
    const int gw = F.vcu * NWAVES + F.wave, NGW = F.G * NWAVES;
    const int per = (K / 64) * (N / 64), total = per * nmat;
    for (int it = gw; it < total; it += NGW) {
        const int mi = it / per, r = it % per;
        p0_transpose_item<RECPERM>(W + (size_t)mi * K * N, K, N, WT + (size_t)mi * K * N, scr, r, F.lane);
    }
}

__device__ const double kInvFreq[16] = {1.0, 0.44036660267178046, 0.19392274474868576, 0.08539710028576561, 0.03760603093086393, 0.016560440080994446, 0.007292664737217109, 0.003211445994752591,
    0.001414213562373095, 0.000622772421914596, 0.0002742481756762073, 0.00012076973741146504, 5.318295896944988e-05, 2.341999896140934e-05, 1.031338537721246e-05, 4.5416704806078695e-06};
__device__ __forceinline__ void p0_tables(Frame& F, const int* positions, const float* rlb, float* cs, float* sn, float* lbt) {
    const int gt = F.vcu * NWAVES * 64 + F.tid, NT = F.G * NWAVES * 64;
    for (int i = gt; i < M * 16; i += NT) {
        const int m = i >> 4, f = i & 15;
        const double invf = kInvFreq[f];
        double ang = (double)positions[m] * invf;
        ang -= 6.283185307179586476925 * (double)__builtin_rint(ang * 0.15915494309189533577);
        const float ar = (float)ang;
        cs[i] = cosf(ar); sn[i] = sinf(ar);
    }
    for (int c = gt; c < 2048; c += NT) {
        const float r0 = rlb[c], r1 = rlb[2048 + c];
        const float mx = fmaxf(r0, r1), e0 = expf(r0 - mx), e1 = expf(r1 - mx);
        const float lb1 = e1 / (e0 + e1);
        lbt[0 * 4096 + c] = 1e-30f;            lbt[0 * 4096 + 2048 + c] = 1.0f;
        lbt[1 * 4096 + c] = fmaxf(lb1, 1e-30f); lbt[1 * 4096 + 2048 + c] = 1.0f - lb1;
    }
}

__device__ __forceinline__ void phase_thin(Frame& F, const float* Y, const float* hin, float* hout, const float* gpost, const float* gpre, bf16* XN) {
    const int gw = F.vcu * NWAVES + F.wave, NGW = F.G * NWAVES;
    for (int m = gw; m < M; m += NGW) {
        const f32x4* hr = (const f32x4*)(hin + (size_t)m * D) + F.lane;
        f32x4 hv[8];
#pragma unroll
        for (int j = 0; j < 8; ++j) hv[j] = hr[64 * j];
        if (Y) {
            const f32x4* yr = (const f32x4*)(Y + (size_t)m * D) + F.lane;
            f32x4 yv[8]; float ss = 0.f;
#pragma unroll
            for (int j = 0; j < 8; ++j) { yv[j] = yr[64 * j]; ss += (yv[j].x * yv[j].x + yv[j].y * yv[j].y) + (yv[j].z * yv[j].z + yv[j].w * yv[j].w); }
            const float r1 = 1.0f / sqrtf(wave_sum(ss) * (1.0f / D) + NORM_EPS);
#pragma unroll
            for (int j = 0; j < 8; ++j) { const f32x4 g = ((const f32x4*)gpost)[F.lane + 64 * j]; hv[j] = hv[j] + yv[j] * r1 * g; }
        }
        f32x4* ho = (f32x4*)(hout + (size_t)m * D) + F.lane;
#pragma unroll
        for (int j = 0; j < 8; ++j) ho[64 * j] = hv[j];
        if (XN) {
            float s2 = 0.f;
#pragma unroll
            for (int j = 0; j < 8; ++j) s2 += (hv[j].x * hv[j].x + hv[j].y * hv[j].y) + (hv[j].z * hv[j].z + hv[j].w * hv[j].w);
            const float r2 = 1.0f / sqrtf(wave_sum(s2) * (1.0f / D) + NORM_EPS);
            unsigned long long* o8 = (unsigned long long*)(XN + (size_t)m * D) + F.lane;
#pragma unroll
            for (int j = 0; j < 8; ++j) { const f32x4 g = ((const f32x4*)gpre)[F.lane + 64 * j]; const f32x4 o = hv[j] * r2 * g;
                o8[64 * j] = (unsigned long long)pk2(o.x, o.y) | ((unsigned long long)pk2(o.z, o.w) << 32); }
        }
    }
}

__device__ __forceinline__ float dot128_bf16(const bf16* a, const bf16* b) {
    float s = 0.f;
#pragma unroll
    for (int i = 0; i < 16; ++i) { const v4u x = *(const v4u*)(a + 8 * i), y = *(const v4u*)(b + 8 * i);
        s += bflo(x.x) * bflo(y.x) + bfhi(x.x) * bfhi(y.x) + bflo(x.y) * bflo(y.y) + bfhi(x.y) * bfhi(y.y)
           + bflo(x.z) * bflo(y.z) + bfhi(x.z) * bfhi(y.z) + bflo(x.w) * bflo(y.w) + bfhi(x.w) * bfhi(y.w); }
    return s;
}
__device__ __forceinline__ void phase_attn_naive(Frame& F, const bf16* QKV, float* og, float* lse) {
    const int gw = F.vcu * NWAVES + F.wave, NGW = F.G * NWAVES, lane = F.lane;
    for (int task = gw; task < M * 24; task += NGW) {
        const int m = task / 24, gh = task % 24, g = gh >> 3, h = gh & 7;
        const int b = m / SEQ, t = m % SEQ;
        const int dil = (g == 0) ? 1 : (g == 1 ? 4 : 16);
        const int p = t / dil;
        const bf16* qp = QKV + (size_t)m * ATT_IN + g * 3072 + h * HD;
        float sc[3]; bool ok[3];
#pragma unroll
        for (int kk = 0; kk < 3; ++kk) {
            const int dist = lane + 64 * kk; ok[kk] = (dist <= 128) && (dist <= p);
            sc[kk] = -3.0e38f;
            if (ok[kk]) { const int t2 = t - dist * dil; sc[kk] = dot128_bf16(qp, QKV + (size_t)(b * SEQ + t2) * ATT_IN + g * 3072 + 1024 + h * HD); }
        }
        const float mx = wave_max(fmaxf(fmaxf(sc[0], sc[1]), sc[2]));
        float pe[3]; float ls = 0.f;
#pragma unroll
        for (int kk = 0; kk < 3; ++kk) { pe[kk] = ok[kk] ? exp2f(sc[kk] - mx) : 0.f; ls += pe[kk]; }
        const float l = wave_sum(ls);
        float o0 = 0.f, o1 = 0.f;
        for (int kk = 0; kk < 3; ++kk) {
            const int nmax = (kk == 2) ? 1 : 64;
            for (int sl = 0; sl < nmax; ++sl) {
                const float pk = __shfl(pe[kk], sl);
                const int dist = sl + 64 * kk;
                if (dist <= p && dist <= 128) {
                    const int t2 = t - dist * dil;
                    const unsigned w = *(const unsigned*)(QKV + (size_t)(b * SEQ + t2) * ATT_IN + g * 3072 + 2048 + h * HD + 2 * lane);
                    o0 += pk * bflo(w); o1 += pk * bfhi(w);
                }
            }
        }
        const float inv = 1.0f / l;
        float* op = og + ((size_t)g * M + m) * ATT_OUT + h * HD + 2 * lane;
        op[0] = o0 * inv; op[1] = o1 * inv;
        if (lane == 0) lse[((size_t)g * M + m) * 8 + h] = mx + log2f(l);
    }
}
__device__ __forceinline__ void phase_combine(Frame& F, const float* og, const float* lse, bf16* OB) {
    const int gw = F.vcu * NWAVES + F.wave, NGW = F.G * NWAVES, lane = F.lane;
    for (int m = gw; m < M; m += NGW) {
        const int h = lane >> 3;
        const float l0 = lse[((size_t)0 * M + m) * 8 + h], l1 = lse[((size_t)1 * M + m) * 8 + h], l2 = lse[((size_t)2 * M + m) * 8 + h];
        const float mx = fmaxf(fmaxf(l0, l1), l2);
        float w0 = exp2f(l0 - mx), w1 = exp2f(l1 - mx), w2 = exp2f(l2 - mx);
        const float inv = 1.0f / (w0 + w1 + w2); w0 *= inv; w1 *= inv; w2 *= inv;
        const f32x4* a0 = (const f32x4*)(og + ((size_t)0 * M + m) * ATT_OUT + 16 * lane);
        const f32x4* a1 = (const f32x4*)(og + ((size_t)1 * M + m) * ATT_OUT + 16 * lane);
        const f32x4* a2 = (const f32x4*)(og + ((size_t)2 * M + m) * ATT_OUT + 16 * lane);
        unsigned wds[8];
#pragma unroll
        for (int j = 0; j < 4; ++j) { const f32x4 o = a0[j] * w0 + a1[j] * w1 + a2[j] * w2; wds[2 * j] = pk2(o.x, o.y); wds[2 * j + 1] = pk2(o.z, o.w); }
        v4u* dst = (v4u*)(OB + (size_t)m * ATT_OUT + 16 * lane);
        dst[0] = (v4u){wds[0], wds[1], wds[2], wds[3]}; dst[1] = (v4u){wds[4], wds[5], wds[6], wds[7]};
    }
}

__device__ __forceinline__ void phase_hgrn_naive(Frame& F, const bf16* P, const float* lbt  , float* ho) {
    LAS float* sq = (LAS float*)(F.lds);
    LAS float* sf = sq + 128;
    LAS float* sk = sf + 128;
    LAS float* sv = sk + 128;
    LAS float* part = sv + 128;
    const int tid = F.tid, n = tid & 127, kq = tid >> 7;
    for (int unit = F.vcu; unit < BATCH * 16; unit += F.G) {
        const int b = unit >> 4, h = unit & 15;
        float S[32];
#pragma unroll
        for (int i = 0; i < 32; ++i) S[i] = 0.f;
        for (int t = 0; t < SEQ; ++t) {
            const bf16* row = P + (size_t)(b * SEQ + t) * REC_IN + 512 * h;
            if (tid < 128) {
                const float q = bf2f(row[tid]), z = bf2f(row[128 + tid]), v = bf2f(row[256 + tid]);
                const float lbc = lbt[h * 128 + tid], oml = lbt[2048 + h * 128 + tid];
                const float s = 1.0f / (1.0f + expf(-z));
                sq[tid] = q; sf[tid] = lbc + oml * s; sk[tid] = oml * (1.0f - s); sv[tid] = v;
            }
            __syncthreads();
            const float v = sv[n]; float acc = 0.f;
#pragma unroll
            for (int i = 0; i < 32; ++i) { const int k = kq * 32 + i; S[i] = sf[k] * S[i] + sk[k] * v; acc += sq[k] * S[i]; }
            part[kq * 128 + n] = acc;
            __syncthreads();
            if (tid < 128) ho[(size_t)(b * SEQ + t) * D + h * 128 + tid] = (part[tid] + part[128 + tid]) + (part[256 + tid] + part[384 + tid]);
        }
        __syncthreads();
    }
}
__device__ __forceinline__ void phase_normgate(Frame& F, const float* ho, const bf16* gate, int gld, int ghs, const float* gnorm, bf16* OB) {
    const int gw = F.vcu * NWAVES + F.wave, NGW = F.G * NWAVES, lane = F.lane;
    const f32x4 gn = *(const f32x4*)(gnorm + 4 * (lane & 31));
    for (int m = gw; m < M; m += NGW) {
        const f32x4* orow = (const f32x4*)(ho + (size_t)m * D) + lane;
        unsigned long long* o8 = (unsigned long long*)(OB + (size_t)m * D) + lane;
#pragma unroll
        for (int j = 0; j < 8; ++j) {
            const f32x4 v = orow[64 * j];
            float ss = (v.x * v.x + v.y * v.y) + (v.z * v.z + v.w * v.w);
#pragma unroll
            for (int o = 1; o < 32; o <<= 1) ss += __shfl_xor(ss, o);
            const float r = 1.0f / sqrtf(ss * (1.0f / 128.0f) + NORM_EPS);
            const int h = 2 * j + (lane >> 5);
            const unsigned long long gw8 = *(const unsigned long long*)(gate + (size_t)m * gld + ghs * h + 4 * (lane & 31));
            const unsigned glo = (unsigned)gw8, ghi = (unsigned)(gw8 >> 32);
            const float g0 = bflo(glo), g1 = bfhi(glo), g2 = bflo(ghi), g3 = bfhi(ghi);
            const float s0 = g0 / (1.0f + expf(-g0)), s1 = g1 / (1.0f + expf(-g1)), s2 = g2 / (1.0f + expf(-g2)), s3 = g3 / (1.0f + expf(-g3));
            o8[64 * j] = (unsigned long long)pk2(v.x * r * gn.x * s0, v.y * r * gn.y * s1) | ((unsigned long long)pk2(v.z * r * gn.z * s2, v.w * r * gn.w * s3) << 32);
        }
    }
}


typedef short s16x4 __attribute__((ext_vector_type(4)));
__device__ __forceinline__ unsigned att_off(unsigned row, unsigned ch) { return 256u * row + 16u * (ch ^ (((row & 3) << 2) | ((row >> 2) & 3))); }
struct AttUnit { int g, dil, b, res, blk, h; };
__device__ __forceinline__ void att_decode(int u, AttUnit& a) {
    a.g = u >> 9; const int r = u & 511; a.h = r & 7; const int nbk = r >> 3;
    a.dil = (a.g == 0) ? 1 : (a.g == 1 ? 4 : 16);
    const int nb = 16 / a.dil;
    const int n = nbk / nb; a.blk = nbk % nb; a.b = n / a.dil; a.res = n % a.dil;
}
__device__ __forceinline__ int att_row(const AttUnit& a, int j) { const int p = 128 * (a.blk - 1) + j; return a.b * SEQ + a.res + a.dil * p; }
__device__ __forceinline__ void att_load(const AttUnit& a, const bf16* QKV, int tid, v4u (&kr)[8], v4u (&vr)[8]) {
#pragma unroll
    for (int i = 0; i < 8; ++i) {
        const int idx = tid + 512 * i, row = idx >> 4, ch = idx & 15;
        if (a.blk > 0 || row >= 128) {
            const bf16* p = QKV + (size_t)att_row(a, row) * ATT_IN + a.g * 3072 + a.h * HD + ch * 8;
            kr[i] = *(const v4u*)(p + 1024); vr[i] = *(const v4u*)(p + 2048);
        } else { kr[i] = (v4u){0u, 0u, 0u, 0u}; vr[i] = (v4u){0u, 0u, 0u, 0u}; }
    }
}
__device__ __forceinline__ void phase_attn(Frame& F, const bf16* QKV, float* og, float* lse) {
    LAS unsigned char* Ks = F.lds; LAS unsigned char* Vs = F.lds + 65536;
    const int tid = F.tid, lane = F.lane, w = F.wave, li = lane & 15, g4 = lane >> 4;
    const int nunits = 1536;
    int u = blockIdx.x;
    if (u >= nunits) return;
    AttUnit a; att_decode(u, a);
    v4u kr[8], vr[8];
    att_load(a, QKV, tid, kr, vr);
    const int wb = (w < 6) ? w : 6;
    for (;;) {
#pragma unroll
        for (int i = 0; i < 8; ++i) { const int idx = tid + 512 * i, row = idx >> 4, ch = idx & 15; const unsigned o = att_off(row, ch);
            *(LAS v4u*)(Ks + o) = kr[i]; *(LAS v4u*)(Vs + o) = vr[i]; }
        const int qi = 16 * w + li;
        const int mq = att_row(a, 128 + qi);
        bf16x8 qf[4];
        { const bf16* qp = QKV + (size_t)mq * ATT_IN + a.g * 3072 + a.h * HD + 8 * g4;
#pragma unroll
          for (int ks = 0; ks < 4; ++ks) qf[ks] = *(const bf16x8*)(qp + 32 * ks); }
        __syncthreads();
        const AttUnit cur = a;
        const int un = u + gridDim.x; const bool has_next = un < nunits;
        if (has_next) { att_decode(un, a); att_load(a, QKV, tid, kr, vr); }
        f32x4 s[10];
#pragma unroll
        for (int tt = 0; tt < 10; ++tt) {
            s[tt] = (f32x4){0.f, 0.f, 0.f, 0.f};
            const unsigned krow = 16 * (wb + tt) + li;
#pragma unroll
            for (int ks = 0; ks < 4; ++ks) { const bf16x8 kf = *(const LAS bf16x8*)(Ks + att_off(krow, 4 * ks + g4));
                s[tt] = __builtin_amdgcn_mfma_f32_16x16x32_bf16(kf, qf[ks], s[tt], 0, 0, 0); }
        }
        float mx = -1.0e30f;
#pragma unroll
        for (int tt = 0; tt < 10; ++tt)
#pragma unroll
            for (int r = 0; r < 4; ++r) { const int j = 16 * (wb + tt) + 4 * g4 + r;
                const bool ok = (j >= qi) && (j <= qi + 128) && (cur.blk > 0 || j >= 128);
                s[tt][r] = ok ? s[tt][r] : -1.0e30f; mx = fmaxf(mx, s[tt][r]); }
        mx = fmaxf(mx, __shfl_xor(mx, 16)); mx = fmaxf(mx, __shfl_xor(mx, 32));
        float ls = 0.f;
#pragma unroll
        for (int tt = 0; tt < 10; ++tt)
#pragma unroll
            for (int r = 0; r < 4; ++r) { const float p = (s[tt][r] > -1.0e29f) ? exp2f(s[tt][r] - mx) : 0.f; s[tt][r] = p; ls += p; }
        ls += __shfl_xor(ls, 16); ls += __shfl_xor(ls, 32);
        bf16x8 pf[5];
#pragma unroll
        for (int ps = 0; ps < 5; ++ps) { const unsigned w0 = pk2(s[2 * ps][0], s[2 * ps][1]), w1 = pk2(s[2 * ps][2], s[2 * ps][3]), w2 = pk2(s[2 * ps + 1][0], s[2 * ps + 1][1]), w3 = pk2(s[2 * ps + 1][2], s[2 * ps + 1][3]);
            const v4u t4 = {w0, w1, w2, w3}; pf[ps] = __builtin_bit_cast(bf16x8, t4); }
        const float inv = 1.0f / ls;
        const int q4 = li >> 2, p4 = li & 3;
        float* orow = og + ((size_t)cur.g * M + mq) * ATT_OUT + cur.h * HD + 4 * g4;
#pragma unroll
        for (int c = 0; c < 8; ++c) {
            f32x4 o = {0.f, 0.f, 0.f, 0.f};
#pragma unroll
            for (int ps = 0; ps < 5; ++ps) {
                const unsigned r0 = 16 * (wb + 2 * ps) + 4 * g4 + q4, r1 = r0 + 16;
                const s16x4 va = __builtin_amdgcn_ds_read_tr16_b64_v4i16((LAS s16x4*)(Vs + att_off(r0, 2 * c + (p4 >> 1)) + 8 * (p4 & 1)));
                const s16x4 vb = __builtin_amdgcn_ds_read_tr16_b64_v4i16((LAS s16x4*)(Vs + att_off(r1, 2 * c + (p4 >> 1)) + 8 * (p4 & 1)));
                const bf16x8 vf = {va[0], va[1], va[2], va[3], vb[0], vb[1], vb[2], vb[3]};
                o = __builtin_amdgcn_mfma_f32_16x16x32_bf16(vf, pf[ps], o, 0, 0, 0);
            }
            *(f32x4*)(orow + 16 * c) = o * inv;
        }
        if (g4 == 0) lse[((size_t)cur.g * M + mq) * 8 + cur.h] = mx + log2f(ls);
        if (!has_next) break;
        u = un;
        __syncthreads();
    }
}

constexpr int SEG = 256, NSEG = SEQ / SEG, NCHUNK = SEG / 16, NUNIT_SCAN = BATCH * 16 * NSEG;
constexpr int SCAN_BUF = 4 * 4096 + 512;
struct ScanPtrs { const bf16 *QT, *KT, *KH, *VV; const float* DL; float* E; float* Dseg; float* ho; };
template <bool OUT>
__device__ __forceinline__ void scan_load(const ScanPtrs& P, int m0c, int cb, int tid, v4u (&r)[3]) {
    const int row = (tid & 255) >> 4, ch = tid & 15; const size_t off = (size_t)(m0c + row) * 2048 + cb + ch * 8;
    if (OUT) r[0] = *(const v4u*)(((tid < 256) ? P.QT : P.KT) + off);
    r[1] = *(const v4u*)(((tid < 256) ? P.KH : P.VV) + off);
    if (tid < 32) r[2] = *(const v4u*)(P.DL + (size_t)(m0c >> 4) * 2048 + cb + tid * 4);
}
template <bool OUT>
__device__ __forceinline__ void scan_store_lds(LAS unsigned char* buf, int tid, const v4u (&r)[3]) {
    const int row = (tid & 255) >> 4, ch = tid & 15; const unsigned o = att_off(row, ch) + ((tid < 256) ? 0u : 4096u);
    if (OUT) *(LAS v4u*)(buf + o) = r[0];
    *(LAS v4u*)(buf + 8192 + o) = r[1];
    if (tid < 32) *(LAS v4u*)(buf + 16384 + tid * 16) = r[2];
}
template <bool OUT, int SEG_ = SEG>
__device__ __forceinline__ void phase_scan(Frame& F, const ScanPtrs P) {
    constexpr int NSEG_ = SEQ / SEG_, NCHUNK_ = SEG_ / 16, NUNIT_ = BATCH * 16 * NSEG_;
    const int tid = F.tid, lane = F.lane, w = F.wave, li = lane & 15, g4 = lane >> 4, q4 = li >> 2, p4 = li & 3;
    for (int unit = blockIdx.x; unit < NUNIT_; unit += gridDim.x) {
        const int seg = unit % NSEG_, bh = unit / NSEG_, b = bh >> 4, h = bh & 15;
        const int m0 = b * SEQ + seg * SEG_, cb = h * 128;
        f32x4 S[8];
        if (OUT && seg > 0) {
            const float* e = P.E + (size_t)(unit - 1) * 16384 + 16 * w + li;
#pragma unroll
            for (int kt = 0; kt < 8; ++kt)
#pragma unroll
                for (int r = 0; r < 4; ++r) S[kt][r] = e[(16 * kt + 4 * g4 + r) * 128];
        } else {
#pragma unroll
            for (int kt = 0; kt < 8; ++kt) S[kt] = (f32x4){0.f, 0.f, 0.f, 0.f};
        }
        f32x4 dprod[8];
        if (!OUT) {
#pragma unroll
            for (int kt = 0; kt < 8; ++kt) dprod[kt] = (f32x4){1.f, 1.f, 1.f, 1.f};
        }
        v4u rg[3];
        scan_load<OUT>(P, m0, cb, tid, rg);
        scan_store_lds<OUT>(F.lds, tid, rg);
        scan_load<OUT>(P, m0 + 16, cb, tid, rg);
        __syncthreads();
        for (int c = 0; c < NCHUNK_; ++c) {
            LAS unsigned char* buf = F.lds + (c & 1) * SCAN_BUF;
            if (c + 1 < NCHUNK_) scan_store_lds<OUT>(F.lds + ((c + 1) & 1) * SCAN_BUF, tid, rg);
            if (c + 2 < NCHUNK_) scan_load<OUT>(P, m0 + 16 * (c + 2), cb, tid, rg);
#if defined(SCAN_SAFE)
            __syncthreads();
#endif
            const s16x4 vf = __builtin_amdgcn_ds_read_tr16_b64_v4i16((LAS s16x4*)(buf + 12288 + att_off(4 * g4 + q4, 2 * w + (p4 >> 1)) + 8 * (p4 & 1)));
            if (OUT) {
                bf16x8 qf[4], kf[4];
#pragma unroll
                for (int ks = 0; ks < 4; ++ks) {
                    const unsigned o0 = att_off(li, 4 * ks + (g4 >> 1)) + 8 * (g4 & 1), o1 = att_off(li, 4 * ks + 2 + (g4 >> 1)) + 8 * (g4 & 1);
                    const s16x4 qa = *(const LAS s16x4*)(buf + o0), qb = *(const LAS s16x4*)(buf + o1);
                    const s16x4 ka = *(const LAS s16x4*)(buf + 4096 + o0), kb = *(const LAS s16x4*)(buf + 4096 + o1);
                    qf[ks] = (bf16x8){qa[0], qa[1], qa[2], qa[3], qb[0], qb[1], qb[2], qb[3]};
                    kf[ks] = (bf16x8){ka[0], ka[1], ka[2], ka[3], kb[0], kb[1], kb[2], kb[3]};
                }
                f32x4 at = {0.f, 0.f, 0.f, 0.f};
#pragma unroll
                for (int ks = 0; ks < 4; ++ks) at = __builtin_amdgcn_mfma_f32_16x16x32_bf16(kf[ks], qf[ks], at, 0, 0, 0);
#pragma unroll
                for (int r = 0; r < 4; ++r) at[r] = (4 * g4 + r <= li) ? at[r] : 0.f;
                const unsigned a01 = pk2(at[0], at[1]), a23 = pk2(at[2], at[3]);
                const s16x4 af = {(short)(a01 & 0xffff), (short)(a01 >> 16), (short)(a23 & 0xffff), (short)(a23 >> 16)};
                f32x4 o = {0.f, 0.f, 0.f, 0.f};
#pragma unroll
                for (int ks = 0; ks < 4; ++ks) {
                    const v4u sw = {pk2(S[2 * ks][0], S[2 * ks][1]), pk2(S[2 * ks][2], S[2 * ks][3]), pk2(S[2 * ks + 1][0], S[2 * ks + 1][1]), pk2(S[2 * ks + 1][2], S[2 * ks + 1][3])};
                    o = __builtin_amdgcn_mfma_f32_16x16x32_bf16(__builtin_bit_cast(bf16x8, sw), qf[ks], o, 0, 0, 0);
                }
                { const f32x4 o2 = __builtin_amdgcn_mfma_f32_16x16x16bf16_1k(vf, af, (f32x4){0.f, 0.f, 0.f, 0.f}, 0, 0, 0); o = o + o2; }
                *(f32x4*)(P.ho + (size_t)(m0 + 16 * c + li) * 2048 + cb + 16 * w + 4 * g4) = o;
            }
#pragma unroll
            for (int kt = 0; kt < 8; ++kt) {
                const s16x4 khf = __builtin_amdgcn_ds_read_tr16_b64_v4i16((LAS s16x4*)(buf + 8192 + att_off(4 * g4 + q4, 2 * kt + (p4 >> 1)) + 8 * (p4 & 1)));
                const f32x4 dl = *(const LAS f32x4*)(buf + 16384 + (16 * kt + 4 * g4) * 4);
                if (!OUT) dprod[kt] = dprod[kt] * dl;
                S[kt] = __builtin_amdgcn_mfma_f32_16x16x16bf16_1k(khf, vf, S[kt] * dl, 0, 0, 0);
            }
            __syncthreads();
        }
        if (!OUT) {
            float* e = P.E + (size_t)unit * 16384 + 16 * w + li;
#pragma unroll
            for (int kt = 0; kt < 8; ++kt)
#pragma unroll
                for (int r = 0; r < 4; ++r) e[(16 * kt + 4 * g4 + r) * 128] = S[kt][r];
            if (w == 0 && li == 0) {
#pragma unroll
                for (int kt = 0; kt < 8; ++kt) *(f32x4*)(P.Dseg + (size_t)unit * 128 + 16 * kt + 4 * g4) = dprod[kt];
            }
        }
    }
}
__device__ __forceinline__ void phase_carry(Frame& F, float* E, const float* Dseg) {
    const int gt = F.vcu * NWAVES * 64 + F.tid, NT = F.G * NWAVES * 64;
    for (int i = gt; i < BATCH * 16 * 4096; i += NT) {
        const int bh = i >> 12, e4 = i & 4095, k = e4 >> 5;
        f32x4 acc = *(const f32x4*)(E + ((size_t)bh * NSEG) * 16384 + e4 * 4);
        for (int s = 1; s < NSEG - 1; ++s) {
            float* p = E + ((size_t)bh * NSEG + s) * 16384 + e4 * 4;
            const float d = Dseg[((size_t)bh * NSEG + s) * 128 + k];
            acc = acc * d + *(const f32x4*)p;
            *(f32x4*)p = acc;
        }
    }
}

struct Args { const float* in[11]; float* out; unsigned char* ws; };

__device__ __forceinline__ void frame_refresh(Frame& F) {
    int t = threadIdx.x; asm volatile("" : "+v"(t)); F.tid = t; F.lane = t & 63; F.wave = __builtin_amdgcn_readfirstlane(t >> 6);
}
__device__ __forceinline__ void frame_init(Frame& F, unsigned char* lds, unsigned char* ws) {
    F.lds = (LAS unsigned char*)lds;
    F.MISC = (volatile LAS unsigned*)(F.lds + MISC_OFF);
    F.tid = threadIdx.x; F.lane = F.tid & 63; F.wave = __builtin_amdgcn_readfirstlane(F.tid >> 6);
    F.G = gridDim.x; { const int bx = blockIdx.x; F.vcu = (F.G % 8 == 0) ? (bx % 8) * (F.G / 8) + bx / 8 : bx; }
    F.ctl = (gu32*)(ws + WS_CTL);
}


__device__ __noinline__ void grid_bar_call(unsigned* barw, unsigned x, volatile LAS unsigned* st) { XcdBarrier b; b.bar = barw; b.x = x; b.st = st; xcd_barrier(b); }
__global__ void __launch_bounds__(NWAVES * 64, 2) mega_fwd(Args args) {
    extern __shared__ __attribute__((aligned(16))) unsigned char lds[];
    Frame F; frame_init(F, lds, args.ws);
    unsigned char* ws = args.ws;
    const float* x = args.in[0]; const int* positions = (const int*)args.in[1]; const float* gains = args.in[2];
    const float* w_att_in = args.in[3]; const float* w_att_out = args.in[4]; const float* w_rec_in = args.in[5];
    const float* rlb = args.in[6]; const float* rec_norm = args.in[7]; const float* w_rec_out = args.in[8];
    const float* w_ff1 = args.in[9]; const float* w_ff2 = args.in[10];
    float* hbuf = args.out;
    bf16* XN = (bf16*)(ws + WS_XN); bf16* BIG = (bf16*)(ws + WS_BIG); float* Y = (float*)(ws + WS_Y); bf16* OB = (bf16*)(ws + WS_OB);
    float* cs = (float*)(ws + WS_ROPE); float* sn = cs + M * 16; float* lbt = (float*)(ws + WS_LB);
    for (int u = F.tid; u < (LDS_BYTES - LDSCTL_OFF) / 4; u += NWAVES * 64) ((LAS unsigned*)(F.lds + LDSCTL_OFF))[u] = 0u;
    __syncthreads();
    XcdBarrier bar = xcd_barrier_post((unsigned*)(F.ctl + CW_BAR), F.MISC + 8);
#define GRID_BAR() grid_bar_call(bar.bar, bar.x, bar.st)

    p0_transpose<false>(F, w_att_in, D, ATT_IN, (bf16*)(ws + WS_WATTIN), 2);
    p0_transpose<false>(F, w_att_out, ATT_OUT, D, (bf16*)(ws + WS_WATTOUT), 2);
    p0_transpose<true>(F, w_rec_in, D, REC_IN, (bf16*)(ws + WS_WRECIN), 2);
    p0_transpose<false>(F, w_rec_out, D, D, (bf16*)(ws + WS_WRECOUT), 2);
    p0_transpose<false>(F, w_ff1, D, DFF, (bf16*)(ws + WS_WFF1), 4);
    p0_transpose<false>(F, w_ff2, DFF, D, (bf16*)(ws + WS_WFF2), 4);
    p0_tables(F, positions, rlb, cs, sn, lbt);
    phase_thin(F, nullptr, x, hbuf, nullptr, gains, XN);
    GRID_BAR();

    for (int layer = 0; layer < DEPTH; ++layer) {
        const int j = layer >> 1;
        const float* g = gains + (size_t)layer * 4 * D;
        if ((layer & 1) == 0) {
            {   pg8::Gemm gm{XN, (const bf16*)(ws + WS_WATTIN) + (size_t)j * ATT_IN * D, M, ATT_IN, D}; pg8::StaticOrder S; S.init(M, ATT_IN, F.G, (int)blockIdx.x);
                pg8::EpiQKV E{BIG, ATT_IN, cs, sn, QSCALE};
                pg8::gemm_phase<pg8::EpiQKV, pg8::StaticOrder, true, true>(F.lds, gm, S, E); }
            GRID_BAR();
            frame_refresh(F); phase_attn(F, BIG, (float*)(ws + WS_AUX + AUX_OG), (float*)(ws + WS_AUX + AUX_LSE));
            GRID_BAR();
            frame_refresh(F); phase_combine(F, (const float*)(ws + WS_AUX + AUX_OG), (const float*)(ws + WS_AUX + AUX_LSE), OB);
            GRID_BAR();
            {   pg8::Gemm gm{OB, (const bf16*)(ws + WS_WATTOUT) + (size_t)j * D * ATT_OUT, M, D, ATT_OUT}; pg8::StaticOrder S; S.init(M, D, F.G, (int)blockIdx.x);
                pg8::EpiF32 E{Y, D};
                pg8::gemm_phase<pg8::EpiF32, pg8::StaticOrder, true, true>(F.lds, gm, S, E); }
            GRID_BAR();
        } else {
            bf16* QT = BIG; bf16* KT = BIG + (size_t)M * 2048; bf16* KH = BIG + (size_t)2 * M * 2048; bf16* VV = BIG + (size_t)3 * M * 2048; bf16* GT = BIG + (size_t)4 * M * 2048;
            float* DL = (float*)(ws + WS_AUX + AUX_DL); float* EST = (float*)(ws + WS_AUX + AUX_E); float* DSEG = (float*)(ws + WS_AUX + AUX_DSEG); float* HO = (float*)(ws + WS_AUX + AUX_HO);
            {   pg8::Gemm gm{XN, (const bf16*)(ws + WS_WRECIN) + (size_t)j * REC_IN * D, M, REC_IN, D}; pg8::StaticOrder S; S.init(M, REC_IN, F.G, (int)blockIdx.x);
                pg8::EpiRec E{QT, KT, KH, VV, GT, DL, lbt + (size_t)j * 4096};
                pg8::gemm_phase<pg8::EpiRec, pg8::StaticOrder, true, true>(F.lds, gm, S, E); }
            GRID_BAR();
            frame_refresh(F); phase_scan<false>(F, ScanPtrs{QT, KT, KH, VV, DL, EST, DSEG, HO});
            GRID_BAR();
            frame_refresh(F); phase_carry(F, EST, DSEG);
            GRID_BAR();
            frame_refresh(F); phase_scan<true>(F, ScanPtrs{QT, KT, KH, VV, DL, EST, DSEG, HO});
            GRID_BAR();
            frame_refresh(F); phase_normgate(F, HO, GT, 2048, 128, rec_norm + (size_t)j * HD, OB);
            GRID_BAR();
            {   pg8::Gemm gm{OB, (const bf16*)(ws + WS_WRECOUT) + (size_t)j * D * D, M, D, D}; pg8::StaticOrder S; S.init(M, D, F.G, (int)blockIdx.x);
                pg8::EpiF32 E{Y, D};
                pg8::gemm_phase<pg8::EpiF32, pg8::StaticOrder, true, true>(F.lds, gm, S, E); }
            GRID_BAR();
        }
        frame_refresh(F); phase_thin(F, Y, hbuf, hbuf, g + D, g + 2 * D, XN);
        GRID_BAR();
        {   pg8::Gemm gm{XN, (const bf16*)(ws + WS_WFF1) + (size_t)layer * DFF * D, M, DFF, D}; pg8::StaticOrder S; S.init(M, DFF, F.G, (int)blockIdx.x);
            pg8::EpiBf16<1> E{BIG, DFF};
            pg8::gemm_phase<pg8::EpiBf16<1>, pg8::StaticOrder, true, true>(F.lds, gm, S, E); }
        GRID_BAR();
        {   pg8::Gemm gm{BIG, (const bf16*)(ws + WS_WFF2) + (size_t)layer * D * DFF, M, D, DFF}; pg8::StaticOrder S; S.init(M, D, F.G, (int)blockIdx.x);
            pg8::EpiF32 E{Y, D};
            pg8::gemm_phase<pg8::EpiF32, pg8::StaticOrder, true, true>(F.lds, gm, S, E); }
        GRID_BAR();
        {   const bool last = (layer == DEPTH - 1);
            frame_refresh(F); phase_thin(F, Y, hbuf, hbuf, g + 3 * D, last ? nullptr : (g + 4 * D), last ? nullptr : XN); }
        if (layer != DEPTH - 1) GRID_BAR();
    }
    if (xb_ld(bar.bar + XB_TMO) != 0u) {
        const int gw = F.vcu * NWAVES + F.wave, NGW = F.G * NWAVES; const float q = __builtin_nanf("");
        for (int m = gw; m < M; m += NGW) { f32x4* o = (f32x4*)(hbuf + (size_t)m * D) + F.lane;
#pragma unroll
            for (int jj = 0; jj < 8; ++jj) o[64 * jj] = (f32x4){q, q, q, q}; }
    }
#undef GRID_BAR
}

extern "C" void kernel_launch(void* const* d_in, const int* in_sizes, int n_in, void* d_out, int out_size, void* d_ws, size_t ws_size, hipStream_t stream) {
    static int grid = 0;
    if (grid == 0) {
        if (n_in != 11 || out_size != M * D || ws_size < WS_END) { fprintf(stderr, "kernel_launch: unexpected shapes (n_in %d, out %d, ws %zu)\n", n_in, out_size, ws_size); grid = -1; return; }
        int dev = 0, cus = 0, per_cu = 0;
        if (hipGetDevice(&dev) != hipSuccess || hipDeviceGetAttribute(&cus, hipDeviceAttributeMultiprocessorCount, dev) != hipSuccess) { grid = -1; return; }
        if (hipFuncSetAttribute((const void*)mega_fwd, hipFuncAttributeMaxDynamicSharedMemorySize, LDS_BYTES) != hipSuccess) { grid = -1; return; }
        if (hipOccupancyMaxActiveBlocksPerMultiprocessor(&per_cu, (const void*)mega_fwd, NWAVES * 64, LDS_BYTES) != hipSuccess || per_cu < 1)
            fprintf(stderr, "kernel_launch: note: occupancy query reports %d workgroups per CU\n", per_cu);
        (void)hipGetLastError();
        grid = cus;
    }
    if (grid < 0) return;
    (void)hipMemsetAsync((char*)d_ws + WS_CTL, 0, CTL_ZERO_BYTES, stream);
    Args a{};
    for (int i = 0; i < 11; ++i) a.in[i] = (const float*)d_in[i];
    a.out = (float*)d_out; a.ws = (unsigned char*)d_ws;
    hipLaunchKernelGGL(mega_fwd, dim3(grid), dim3(NWAVES * 64), LDS_BYTES, stream, a);
}
```
